# Optimizing an MI355X kernel written in HIP

```python
import math
import jax, jax.numpy as jnp
from jax import lax
import numpy as np

D_MODEL = 2048
BATCH = 4
SEQ = 2048
DEPTH = 1
DEC_BATCH = 128
DEC_SEQ = 1
PAST_LEN = 16384
PAGE_SIZE = 128

N_MEM = 256
S5_WIDTH = D_MODEL // 2
S5_GROUP = 16
S5_GROUPS = S5_WIDTH // S5_GROUP
S5_STATE = 64
DT_MIN = 1e-3
DT_MAX = 1e-1
ML_WIDTH = D_MODEL // 2
ML_HEADS = 4
ML_HEAD_DIM = ML_WIDTH // ML_HEADS
ML_CHUNK = 64
XA_WIDTH = D_MODEL // 2
XA_HEADS = 4
XA_HEAD_DIM = XA_WIDTH // XA_HEADS
N_BRANCH = 3
FF_DIM = 5504
EPS = 1e-6

IN_SIZES = (S5_WIDTH, ML_WIDTH, ML_WIDTH, ML_WIDTH, ML_WIDTH, ML_HEADS, ML_HEADS, XA_WIDTH, N_BRANCH * D_MODEL)
D_IN = sum(IN_SIZES)
IN_SPLIT = tuple(int(c) for c in np.cumsum(IN_SIZES)[:-1])

kernel_name = "hybrid_s5_mlstm_memxattn_decode_step"


def rmsnorm(x, g):
    xf = x.astype(jnp.float32)
    r = lax.rsqrt(jnp.mean(xf * xf, axis=-1, keepdims=True) + EPS)
    return (xf * r).astype(x.dtype) * g


def swiglu(x, w_gate, w_up, w_down):
    return (jax.nn.silu(x @ w_gate) * (x @ w_up)) @ w_down


def _complex_affine_combine(e1, e2):
    a1r, a1i, b1r, b1i = e1
    a2r, a2i, b2r, b2i = e2
    return (a2r * a1r - a2i * a1i, a2r * a1i + a2i * a1r,
            a2r * b1r - a2i * b1i + b2r, a2r * b1i + a2i * b1r + b2i)


def s5_branch(u, s_re, s_im, lam_re, lam_im, log_step, b_re, b_im, c_re, c_im, d, w_glu):
    bn, L, _ = u.shape
    f32 = jnp.float32
    lam_re = lam_re.astype(f32)
    lam_im = lam_im.astype(f32)
    dt = jnp.exp(log_step.astype(f32))[:, None]
    mag = jnp.exp(lam_re * dt)
    ab_re = mag * jnp.cos(lam_im * dt)
    ab_im = mag * jnp.sin(lam_im * dt)
    den = lam_re * lam_re + lam_im * lam_im
    nr = ab_re - 1.0
    z_re = (nr * lam_re + ab_im * lam_im) / den
    z_im = (ab_im * lam_re - nr * lam_im) / den
    b_re = b_re.astype(f32)
    b_im = b_im.astype(f32)
    bb_re = z_re[..., None] * b_re - z_im[..., None] * b_im
    bb_im = z_re[..., None] * b_im + z_im[..., None] * b_re
    ug = u.astype(f32).reshape(bn, L, S5_GROUPS, S5_GROUP)
    bu_re = jnp.einsum('blgh,gph->blgp', ug, bb_re)
    bu_im = jnp.einsum('blgh,gph->blgp', ug, bb_im)
    s_re = s_re.astype(f32)
    s_im = s_im.astype(f32)
    bu_re = bu_re.at[:, 0].add(ab_re * s_re - ab_im * s_im)
    bu_im = bu_im.at[:, 0].add(ab_re * s_im + ab_im * s_re)
    a_re = jnp.broadcast_to(ab_re, bu_re.shape)
    a_im = jnp.broadcast_to(ab_im, bu_im.shape)
    _, _, x_re, x_im = lax.associative_scan(_complex_affine_combine, (a_re, a_im, bu_re, bu_im), axis=1)
    y = (jnp.einsum('blgp,ghp->blgh', x_re, c_re.astype(f32))
         - jnp.einsum('blgp,ghp->blgh', x_im, c_im.astype(f32))
         + d.astype(f32) * ug)
    y = jax.nn.gelu(y.reshape(bn, L, S5_WIDTH)).astype(u.dtype)
    y = y * jax.nn.sigmoid(y @ w_glu)
    return y, x_re[:, -1], x_im[:, -1]


def mlstm_branch(q, k, v, i_pre, f_pre, C0, n0, m0):
    bn, L, _ = q.shape
    f32 = jnp.float32
    cl = math.gcd(ML_CHUNK, L)
    nc = L // cl

    def blocks(t):
        return t.astype(f32).reshape(bn, nc, cl, ML_HEADS, ML_HEAD_DIM).transpose(1, 0, 3, 2, 4)

    def gblocks(t):
        return t.astype(f32).reshape(bn, nc, cl, ML_HEADS).transpose(1, 0, 3, 2)

    qb = blocks(q)
    kb = blocks(k) * (ML_HEAD_DIM ** -0.5)
    vb = blocks(v)
    ib = gblocks(i_pre)
    lfb = jax.nn.log_sigmoid(gblocks(f_pre))
    causal = jnp.tril(jnp.ones((cl, cl), dtype=bool))

    def chunk_step(carry, xs):
        C, n, m = carry
        qc, kc, vc, ic, lfc = xs
        bcum = jnp.cumsum(lfc, axis=-1)
        g_inter = bcum + m[..., None]
        dlog = bcum[..., :, None] - bcum[..., None, :] + ic[..., None, :]
        dlog = jnp.where(causal, dlog, -jnp.inf)
        m_t = jnp.maximum(g_inter, jnp.max(dlog, axis=-1))
        w_inter = jnp.exp(g_inter - m_t)
        w_intra = jnp.exp(dlog - m_t[..., None])
        s = jnp.einsum('bhtd,bhsd->bhts', qc, kc) * w_intra
        num = jnp.einsum('bhts,bhsv->bhtv', s, vc) + w_inter[..., None] * jnp.einsum('bhtd,bhdv->bhtv', qc, C)
        nq = jnp.sum(s, axis=-1) + w_inter * jnp.einsum('bhtd,bhd->bht', qc, n)
        h = num / jnp.maximum(jnp.abs(nq), jnp.exp(-m_t))[..., None]
        w_last = w_intra[..., -1, :]
        C_new = w_inter[..., -1, None, None] * C + jnp.einsum('bhs,bhsd,bhsv->bhdv', w_last, kc, vc)
        n_new = w_inter[..., -1, None] * n + jnp.einsum('bhs,bhsd->bhd', w_last, kc)
        return (C_new, n_new, m_t[..., -1]), h

    (C, n, m), hb = lax.scan(chunk_step, (C0.astype(f32), n0.astype(f32), m0.astype(f32)),
                             (qb, kb, vb, ib, lfb))
    h = hb.transpose(1, 0, 3, 2, 4).reshape(bn, L, ML_HEADS, ML_HEAD_DIM)
    return h, C, n, m


def memory_kv(mem, g_mem, w_mem_k, w_mem_v):
    bn, nm, _ = mem.shape
    mn = rmsnorm(mem, g_mem)
    k = (mn @ w_mem_k).reshape(bn, nm, XA_HEADS, XA_HEAD_DIM)
    v = (mn @ w_mem_v).reshape(bn, nm, XA_HEADS, XA_HEAD_DIM)
    return k, v


def cross_attention(q, mem_k, mem_v):
    s = jnp.einsum('blhd,bmhd->bhlm', q, mem_k).astype(jnp.float32) * (XA_HEAD_DIM ** -0.5)
    p = jax.nn.softmax(s, axis=-1).astype(mem_v.dtype)
    return jnp.einsum('bhlm,bmhd->blhd', p, mem_v)


def hybrid_layer(x, mem_k, mem_v, s5_re, s5_im, C, n, m, lw):
    bn, L, _ = x.shape
    x = x + 0.5 * swiglu(rmsnorm(x, lw['g_ffn1']), lw['w1_gate'], lw['w1_up'], lw['w1_down'])
    h = rmsnorm(x, lw['g_mix'])
    z = h @ lw['w_in']
    u, q, k, v, o, ig, fg, qx, gates = jnp.split(z, IN_SPLIT, axis=-1)
    s5_out, s5_re, s5_im = s5_branch(u, s5_re, s5_im, lw['s5_lambda_re'], lw['s5_lambda_im'], lw['s5_log_step'],
                                     lw['s5_b_re'], lw['s5_b_im'], lw['s5_c_re'], lw['s5_c_im'], lw['s5_d'],
                                     lw['w_s5_glu'])
    hm, C, n, m = mlstm_branch(q, k, v, ig + lw['b_igate'], fg + lw['b_fgate'], C, n, m)
    hm = rmsnorm(hm.astype(x.dtype), lw['g_mlstm_head'].reshape(ML_HEADS, ML_HEAD_DIM)).reshape(bn, L, ML_WIDTH)
    ml_out = hm * jax.nn.sigmoid(o)
    xa_out = cross_attention(qx.reshape(bn, L, XA_HEADS, XA_HEAD_DIM), mem_k, mem_v).reshape(bn, L, XA_WIDTH)
    gts = jax.nn.sigmoid(gates).reshape(bn, L, N_BRANCH, D_MODEL)
    merged = (gts[:, :, 0] * (s5_out @ lw['w_br_s5'])
              + gts[:, :, 1] * (ml_out @ lw['w_br_ml'])
              + gts[:, :, 2] * (xa_out @ lw['w_br_xa']))
    x = x + merged @ lw['w_out']
    x = x + 0.5 * swiglu(rmsnorm(x, lw['g_ffn2']), lw['w2_gate'], lw['w2_up'], lw['w2_down'])
    return x, (s5_re, s5_im, C, n, m)


def setup_inputs(seed: int = 0) -> dict:
    key = jax.random.key(seed)
    ks = iter(jax.random.split(key, 64))
    f32 = jnp.float32

    def normal(shape, scale):
        return jax.random.normal(next(ks), shape, f32) * scale

    def dense(shape, fan_in):
        return normal(shape, fan_in ** -0.5)

    def gain(shape):
        return 1.0 + normal(shape, 0.02)

    Ld = DEPTH
    G, P, Hg = S5_GROUPS, S5_STATE, S5_GROUP
    inp = {}
    inp['x_prompt'] = normal((BATCH, SEQ, D_MODEL), 1.0)
    inp['x_sample'] = normal((DEC_BATCH, DEC_SEQ, D_MODEL), 1.0)
    inp['mem_prompt'] = normal((BATCH, N_MEM, D_MODEL), 1.0)
    inp['cache_mem_k'] = normal((Ld, DEC_BATCH, N_MEM, XA_HEADS, XA_HEAD_DIM), 1.0)
    inp['cache_mem_v'] = normal((Ld, DEC_BATCH, N_MEM, XA_HEADS, XA_HEAD_DIM), 1.0)
    inp['state_s5_re'] = normal((Ld, DEC_BATCH, G, P), 0.5)
    inp['state_s5_im'] = normal((Ld, DEC_BATCH, G, P), 0.5)
    inp['state_mlstm_C'] = normal((Ld, DEC_BATCH, ML_HEADS, ML_HEAD_DIM, ML_HEAD_DIM), 0.05)
    inp['state_mlstm_n'] = normal((Ld, DEC_BATCH, ML_HEADS, ML_HEAD_DIM), 0.1)
    inp['state_mlstm_m'] = jax.random.uniform(next(ks), (Ld, DEC_BATCH, ML_HEADS), f32, 0.0, 2.0)
    inp['g_ffn1'] = gain((Ld, D_MODEL))
    inp['w1_gate'] = dense((Ld, D_MODEL, FF_DIM), D_MODEL)
    inp['w1_up'] = dense((Ld, D_MODEL, FF_DIM), D_MODEL)
    inp['w1_down'] = dense((Ld, FF_DIM, D_MODEL), FF_DIM)
    inp['g_mix'] = gain((Ld, D_MODEL))
    inp['w_in'] = dense((Ld, D_MODEL, D_IN), D_MODEL)
    inp['s5_lambda_re'] = -0.5 + normal((Ld, G, P), 0.01)
    inp['s5_lambda_im'] = math.pi * jnp.broadcast_to(jnp.arange(P, dtype=f32), (Ld, G, P)) + normal((Ld, G, P), 0.01)
    inp['s5_log_step'] = jax.random.uniform(next(ks), (Ld, G), f32, math.log(DT_MIN), math.log(DT_MAX))
    inp['s5_b_re'] = dense((Ld, G, P, Hg), 2 * Hg)
    inp['s5_b_im'] = dense((Ld, G, P, Hg), 2 * Hg)
    inp['s5_c_re'] = dense((Ld, G, Hg, P), 2 * P)
    inp['s5_c_im'] = dense((Ld, G, Hg, P), 2 * P)
    inp['s5_d'] = normal((Ld, G, Hg), 0.5)
    inp['w_s5_glu'] = dense((Ld, S5_WIDTH, S5_WIDTH), S5_WIDTH)
    inp['b_igate'] = normal((Ld, ML_HEADS), 0.1)
    inp['b_fgate'] = 3.0 + normal((Ld, ML_HEADS), 0.1)
    inp['g_mlstm_head'] = gain((Ld, ML_WIDTH))
    inp['g_mem'] = gain((Ld, D_MODEL))
    inp['w_mem_k'] = dense((Ld, D_MODEL, XA_WIDTH), D_MODEL)
    inp['w_mem_v'] = dense((Ld, D_MODEL, XA_WIDTH), D_MODEL)
    inp['w_br_s5'] = dense((Ld, S5_WIDTH, D_MODEL), S5_WIDTH)
    inp['w_br_ml'] = dense((Ld, ML_WIDTH, D_MODEL), ML_WIDTH)
    inp['w_br_xa'] = dense((Ld, XA_WIDTH, D_MODEL), XA_WIDTH)
    inp['w_out'] = dense((Ld, D_MODEL, D_MODEL), D_MODEL)
    inp['g_ffn2'] = gain((Ld, D_MODEL))
    inp['w2_gate'] = dense((Ld, D_MODEL, FF_DIM), D_MODEL)
    inp['w2_up'] = dense((Ld, D_MODEL, FF_DIM), D_MODEL)
    inp['w2_down'] = dense((Ld, FF_DIM, D_MODEL), FF_DIM)
    inp['g_final'] = gain((D_MODEL,))
    return inp


def reference(x_prompt, x_sample, mem_prompt, cache_mem_k, cache_mem_v,
              state_s5_re, state_s5_im, state_mlstm_C, state_mlstm_n, state_mlstm_m,
              g_ffn1, w1_gate, w1_up, w1_down, g_mix, w_in,
              s5_lambda_re, s5_lambda_im, s5_log_step, s5_b_re, s5_b_im, s5_c_re, s5_c_im, s5_d, w_s5_glu,
              b_igate, b_fgate, g_mlstm_head, g_mem, w_mem_k, w_mem_v,
              w_br_s5, w_br_ml, w_br_xa, w_out, g_ffn2, w2_gate, w2_up, w2_down, g_final):
    f32 = jnp.float32
    bp = x_prompt.shape[0]
    xp, xs = x_prompt, x_sample
    prompt_rows, sample_rows = [], []
    for l in range(DEPTH):
        lw = dict(g_ffn1=g_ffn1[l], w1_gate=w1_gate[l], w1_up=w1_up[l], w1_down=w1_down[l],
                  g_mix=g_mix[l], w_in=w_in[l],
                  s5_lambda_re=s5_lambda_re[l], s5_lambda_im=s5_lambda_im[l], s5_log_step=s5_log_step[l],
                  s5_b_re=s5_b_re[l], s5_b_im=s5_b_im[l], s5_c_re=s5_c_re[l], s5_c_im=s5_c_im[l],
                  s5_d=s5_d[l], w_s5_glu=w_s5_glu[l],
                  b_igate=b_igate[l], b_fgate=b_fgate[l], g_mlstm_head=g_mlstm_head[l],
                  w_br_s5=w_br_s5[l], w_br_ml=w_br_ml[l], w_br_xa=w_br_xa[l], w_out=w_out[l],
                  g_ffn2=g_ffn2[l], w2_gate=w2_gate[l], w2_up=w2_up[l], w2_down=w2_down[l])
        mk_p, mv_p = memory_kv(mem_prompt, g_mem[l], w_mem_k[l], w_mem_v[l])
        s0 = jnp.zeros((bp, S5_GROUPS, S5_STATE), f32)
        C0 = jnp.zeros((bp, ML_HEADS, ML_HEAD_DIM, ML_HEAD_DIM), f32)
        n0 = jnp.zeros((bp, ML_HEADS, ML_HEAD_DIM), f32)
        m0 = jnp.zeros((bp, ML_HEADS), f32)
        xp, st_p = hybrid_layer(xp, mk_p, mv_p, s0, s0, C0, n0, m0, lw)
        prompt_rows.append((mk_p, mv_p) + st_p)
        xs, st_s = hybrid_layer(xs, cache_mem_k[l], cache_mem_v[l], state_s5_re[l], state_s5_im[l],
                                state_mlstm_C[l], state_mlstm_n[l], state_mlstm_m[l], lw)
        sample_rows.append(st_s)
    mk_p, mv_p, s5r_p, s5i_p, C_p, n_p, m_p = [jnp.stack(a) for a in zip(*prompt_rows)]
    s5r_s, s5i_s, C_s, n_s, m_s = [jnp.stack(a) for a in zip(*sample_rows)]
    y_prompt = rmsnorm(xp, g_final)
    y_sample = rmsnorm(xs, g_final)
    return (y_prompt, y_sample, mk_p, mv_p, s5r_p, s5i_p, C_p, n_p, m_p, s5r_s, s5i_s, C_s, n_s, m_s)
```

```cpp
#include <hip/hip_runtime.h>
#include <hip/hip_cooperative_groups.h>
#include <cstdio>
#include <cstdint>
namespace cg = cooperative_groups;
namespace pg8 {
#define PG8_LAS __attribute__((address_space(3)))
typedef unsigned short bf16_t;
typedef short bf16x8 __attribute__((ext_vector_type(8)));
typedef float f32x4 __attribute__((ext_vector_type(4)));
typedef unsigned u32x4 __attribute__((ext_vector_type(4)));
constexpr int BM = 256, BK = 64, HALF = 128, HTB = HALF * BK * 2  , STAGE_BYTES = 8 * HTB, NXCD = 8, WGM = 8;

__host__ __device__ __forceinline__ int lds_byte(int r, int c) { const int st = (r >> 4) * 2 + (c >> 5), rr = r & 15, cc = c & 31, ob = rr * 64 + cc * 2; return st * 1024 + (ob ^ (((ob >> 9) & 1) << 5)); }
__host__ __device__ __forceinline__ void stage_rc(int b, int& R, int& C) { const int st = b / 1024, sb = b % 1024, swz = sb ^ (((sb >> 9) & 1) << 5); R = (st >> 1) * 16 + swz / 64; C = (st & 1) * 32 + (swz % 64) / 2; }
__host__ __device__ __forceinline__ int perm32(int rho) { const int n = rho >> 4, i = rho & 15; return 8 * (i >> 2) + 4 * n + (i & 3); }

struct Unit { int pm, pn, kind, k0, nt, split, slot; };
struct Gemm { int K; };
struct Order {
    const char* A0; const char* B0; long dA, dB;
    int nM0, nN0, dM, dN, n0, ntot, rep, G, c; size_t tstep;
    int ntFull, nsp, spS, spPairs, spPm;
    __device__ __forceinline__ bool next(int i, Unit& u) const {
        int r = 0, ii = i; if (rep > 1) { r = i % rep; ii = i / rep; }
        const long L = (long)ii * G + c;
        if (L < ntot) {
            int id = (int)L; const int s = (id >= n0) ? 1 : 0; id -= s * n0;
            const int nM = nM0 + s * dM, nN = nN0 + s * dN, nwg = nM * nN;
            int wgid = id; { const int q = nwg / NXCD, rr = nwg % NXCD, xcd = wgid % NXCD, off = wgid / NXCD; wgid = (xcd < rr ? xcd * (q + 1) : rr * (q + 1) + (xcd - rr) * q) + off; }
            const int nig = WGM * nN, gid = wgid / nig, fm = gid * WGM, gsz = (nM - fm) < WGM ? (nM - fm) : WGM;
            u.pm = fm + ((wgid % nig) % gsz); u.pn = (wgid % nig) / gsz; u.kind = rep > 1 ? r : s; u.k0 = 0; u.nt = ntFull; u.split = 0; u.slot = 0; return true;
        }
        if (nsp == 0) return false;
        const int rounds_main = (ntot / G) * rep; if (i < rounds_main) return false;
        const long e = (long)(i - rounds_main) * G + c; if (e >= nsp) return false;
        const int ee = (int)e, q = ee >> 3, ks = q % spS, p0 = (ks * spPairs) / spS, p1 = ((ks + 1) * spPairs) / spS;
        u.pm = spPm; u.pn = ee & 7; u.kind = q / spS; u.k0 = 128 * p0; u.nt = 2 * (p1 - p0); u.split = 1; u.slot = q; return true;
    }
    __device__ __forceinline__ const char* aptr(const Unit& u) const { return A0 + (long)u.kind * dA + (size_t)u.pm * tstep + (size_t)u.k0 * 2; }
    __device__ __forceinline__ const char* bptr(const Unit& u) const { return B0 + (long)u.kind * dB + (size_t)u.pn * tstep + (size_t)u.k0 * 2; }
    __device__ __forceinline__ void a_ready(const Unit&) const {}
    __device__ __forceinline__ void done(const Unit&) const {}
};
typedef float cvt_f32x2_t __attribute__((ext_vector_type(2)));
typedef __bf16 cvt_bf16x2_t __attribute__((ext_vector_type(2)));
__device__ __forceinline__ unsigned cvt_pk_bf16(float lo, float hi) { cvt_f32x2_t v = {lo, hi}; cvt_bf16x2_t b = __builtin_convertvector(v, cvt_bf16x2_t); return __builtin_bit_cast(unsigned, b); }
__device__ __forceinline__ int opaque_tid() { int t = threadIdx.x; asm volatile("" : "+v"(t)); return t; }
template <class Epi, class Sched, bool ALIGN_EPI = false, bool SP2 = false>
__device__ __forceinline__ void gemm_phase(PG8_LAS unsigned char* lds, const Gemm g, const Sched& S, const Epi& E) {
    const int tid = opaque_tid(), wid = __builtin_amdgcn_readfirstlane(tid >> 6), lane = tid & 63, wr = wid >> 2, wc = wid & 3, fr = lane & 15, fq = lane >> 4;
    const int K = g.K; int nt = 0;
    unsigned voffA[2], voffB[2];
#pragma unroll
    for (int i = 0; i < 2; ++i) { int R, C; stage_rc(tid * 16 + i * 8192, R, C); const int Rb = Epi::PERM ? ((R & ~31) + perm32(R & 31)) : R;
        voffA[i] = (unsigned)(R * K + C) * 2u; voffB[i] = (unsigned)(Rb * K + C) * 2u; }
    const size_t kstep = (size_t)(BK * 2);
    const size_t hstep = (size_t)HALF * K * 2;
        const unsigned ldsw = (unsigned)wid * 1024u;
    const int aoff = lds_byte(wr * 64 + fr, fq * 8), boff = lds_byte(wc * 32 + fr, fq * 8);
#define PG8_SA(b, h) (((b) * 2 + (h)) * HTB)
#define PG8_SB(b, h) ((4 + (b) * 2 + (h)) * HTB)
#define PG8_STAGE(bufoff, gbase, voff) do { _Pragma("unroll") for (int _i = 0; _i < 2; ++_i) \
        __builtin_amdgcn_global_load_lds((const unsigned*)((const char*)(gbase) + (voff)[_i]), (PG8_LAS unsigned*)(lds + (bufoff) + ldsw + _i * 8192), 16, 0, 0); } while (0)
#define PG8_LDA(dst, b, h) do { _Pragma("unroll") for (int m = 0; m < 4; ++m) _Pragma("unroll") for (int k = 0; k < 2; ++k) dst[m][k] = *(const PG8_LAS bf16x8*)(lds + PG8_SA(b, h) + aoff + m * 2048 + k * 1024); } while (0)
#define PG8_LDB(dst, b, h) do { _Pragma("unroll") for (int n = 0; n < 2; ++n) _Pragma("unroll") for (int k = 0; k < 2; ++k) dst[n][k] = *(const PG8_LAS bf16x8*)(lds + PG8_SB(b, h) + boff + n * 2048 + k * 1024); } while (0)
#define PG8_MMA(ai, bj, At, Bt) do { __builtin_amdgcn_s_setprio(1); _Pragma("unroll") for (int m = 0; m < 4; ++m) _Pragma("unroll") for (int n = 0; n < 2; ++n) _Pragma("unroll") for (int k = 0; k < 2; ++k) \
        acc[ai][bj][m][n] = __builtin_amdgcn_mfma_f32_16x16x32_bf16(Bt[n][k], At[m][k], acc[ai][bj][m][n], 0, 0, 0); __builtin_amdgcn_s_setprio(0); } while (0)
#define PG8_WAIT_V(n) asm volatile("s_waitcnt vmcnt(" #n ")" ::: "memory")
#define PG8_WAIT_L(n) asm volatile("s_waitcnt lgkmcnt(" #n ")" ::: "memory")
#define PG8_BAR __builtin_amdgcn_s_barrier()
#define PG8_SCHED __builtin_amdgcn_sched_barrier(0)
    Unit cur, nxt; int ui = 0;
    if (!S.next(0, cur)) return;
    nt = cur.nt;
    f32x4 acc[2][2][4][2];
#pragma unroll
    for (int a = 0; a < 2; ++a)
#pragma unroll
        for (int b = 0; b < 2; ++b)
#pragma unroll
            for (int m = 0; m < 4; ++m)
#pragma unroll
                for (int n = 0; n < 2; ++n) acc[a][b][m][n] = (f32x4){0.f, 0.f, 0.f, 0.f};
    bf16x8 At[4][2], B0[2][2], B1[2][2];
    const char* cA = S.aptr(cur); const char* cB = S.bptr(cur);
    S.a_ready(cur);
    if constexpr (SP2) {
        PG8_STAGE(PG8_SB(0, 0), cB, voffB); PG8_STAGE(PG8_SB(0, 1), cB + hstep, voffB); PG8_STAGE(PG8_SA(0, 0), cA, voffA); PG8_STAGE(PG8_SA(0, 1), cA + hstep, voffA);
        if (wr == 1) PG8_BAR;
        PG8_WAIT_V(2); PG8_BAR;
        PG8_STAGE(PG8_SB(1, 0), cB + kstep, voffB); PG8_STAGE(PG8_SA(1, 0), cA + kstep, voffA); PG8_STAGE(PG8_SB(1, 1), cB + hstep + kstep, voffB);
        PG8_WAIT_V(6); PG8_BAR;
    } else {
        PG8_STAGE(PG8_SB(0, 0), cB, voffB); PG8_STAGE(PG8_SA(0, 0), cA, voffA); PG8_STAGE(PG8_SB(0, 1), cB + hstep, voffB); PG8_STAGE(PG8_SA(0, 1), cA + hstep, voffA);
        if (wr == 1) PG8_BAR;
        PG8_WAIT_V(4); PG8_BAR;
        PG8_STAGE(PG8_SB(1, 0), cB + kstep, voffB); PG8_STAGE(PG8_SA(1, 0), cA + kstep, voffA); PG8_STAGE(PG8_SB(1, 1), cB + hstep + kstep, voffB);
        PG8_WAIT_V(6); PG8_BAR;
    }
    for (;;) {
        const bool has_next = S.next(ui + 1, nxt);
        const char* nA = has_next ? S.aptr(nxt) : cA; const char* nB = has_next ? S.bptr(nxt) : cB;
        for (int t = 0; t < nt; t += 2) {
            const bool last = (t == nt - 2);
            const char* a1 = cA + (size_t)(t + 1) * kstep;
            const char* a2 = last ? nA : cA + (size_t)(t + 2) * kstep; const char* b2 = last ? nB : cB + (size_t)(t + 2) * kstep;
            const char* a3 = a2 + kstep; const char* b3 = b2 + kstep;
            if (last && has_next) S.a_ready(nxt);
            if constexpr (SP2) {
            PG8_LDB(B0, 0, 0); PG8_LDB(B1, 0, 1); PG8_SCHED; PG8_LDA(At, 0, 0); PG8_STAGE(PG8_SA(1, 1), a1 + hstep, voffA);
            PG8_WAIT_V(8); PG8_WAIT_L(0); PG8_BAR; PG8_MMA(0, 0, At, B0); PG8_MMA(0, 1, At, B1); PG8_BAR; PG8_SCHED;
            PG8_LDA(At, 0, 1); PG8_STAGE(PG8_SB(0, 0), b2, voffB); PG8_STAGE(PG8_SB(0, 1), b2 + hstep, voffB); PG8_STAGE(PG8_SA(0, 0), a2, voffA);
            PG8_WAIT_V(8); PG8_WAIT_L(0); PG8_BAR; PG8_MMA(1, 0, At, B0); PG8_MMA(1, 1, At, B1); PG8_BAR; PG8_SCHED;
            PG8_LDB(B0, 1, 0); PG8_LDB(B1, 1, 1); PG8_SCHED; PG8_LDA(At, 1, 0); PG8_STAGE(PG8_SA(0, 1), a2 + hstep, voffA);
            PG8_WAIT_V(8); PG8_WAIT_L(0); PG8_BAR; PG8_MMA(0, 0, At, B0); PG8_MMA(0, 1, At, B1); PG8_BAR; PG8_SCHED;
            PG8_LDA(At, 1, 1); PG8_STAGE(PG8_SB(1, 0), b3, voffB); PG8_STAGE(PG8_SB(1, 1), b3 + hstep, voffB); PG8_STAGE(PG8_SA(1, 0), a3, voffA);
            PG8_WAIT_V(8); PG8_WAIT_L(0); PG8_BAR; PG8_MMA(1, 0, At, B0); PG8_MMA(1, 1, At, B1); PG8_BAR; PG8_SCHED;
            } else {
            PG8_LDB(B0, 0, 0); PG8_SCHED; PG8_LDA(At, 0, 0); PG8_STAGE(PG8_SA(1, 1), a1 + hstep, voffA);
            PG8_WAIT_L(8); PG8_BAR; PG8_WAIT_L(0); PG8_MMA(0, 0, At, B0); PG8_BAR; PG8_SCHED;
            PG8_LDB(B1, 0, 1); PG8_STAGE(PG8_SB(0, 0), b2, voffB);
            PG8_BAR; PG8_WAIT_L(0); PG8_MMA(0, 1, At, B1); PG8_BAR;
            PG8_LDA(At, 0, 1); PG8_STAGE(PG8_SA(0, 0), a2, voffA);
            PG8_BAR; PG8_WAIT_L(0); PG8_MMA(1, 0, At, B0); PG8_BAR; PG8_SCHED;
            PG8_STAGE(PG8_SB(0, 1), b2 + hstep, voffB);
            PG8_WAIT_V(6); PG8_BAR; PG8_MMA(1, 1, At, B1); PG8_BAR;
            PG8_LDB(B0, 1, 0); PG8_SCHED; PG8_LDA(At, 1, 0); PG8_STAGE(PG8_SA(0, 1), a2 + hstep, voffA);
            PG8_WAIT_L(8); PG8_BAR; PG8_WAIT_L(0); PG8_MMA(0, 0, At, B0); PG8_BAR; PG8_SCHED;
            PG8_LDB(B1, 1, 1); PG8_STAGE(PG8_SB(1, 0), b3, voffB);
            PG8_BAR; PG8_WAIT_L(0); PG8_MMA(0, 1, At, B1); PG8_BAR;
            PG8_LDA(At, 1, 1); PG8_STAGE(PG8_SA(1, 0), a3, voffA);
            PG8_BAR; PG8_WAIT_L(0); PG8_MMA(1, 0, At, B0); PG8_BAR; PG8_SCHED;
            PG8_STAGE(PG8_SB(1, 1), b3 + hstep, voffB);
            PG8_WAIT_V(6); PG8_BAR; PG8_MMA(1, 1, At, B1); PG8_BAR;
            }
        }
        if constexpr (ALIGN_EPI) { if (wr == 0) PG8_BAR; }
        if constexpr (!Epi::AFTER_DRAIN) { E(acc, cur, wr, wc, fr, fq); S.done(cur); }
        if (!has_next) break;
#pragma unroll
        for (int a = 0; a < 2; ++a)
#pragma unroll
            for (int b = 0; b < 2; ++b)
#pragma unroll
                for (int m = 0; m < 4; ++m)
#pragma unroll
                    for (int n = 0; n < 2; ++n) acc[a][b][m][n] = (f32x4){0.f, 0.f, 0.f, 0.f};
        cur = nxt; cA = nA; cB = nB; ++ui; nt = cur.nt;
        if constexpr (ALIGN_EPI) { if (wr == 1) PG8_BAR; }
    }
    PG8_WAIT_V(0);
    if constexpr (!ALIGN_EPI) { if (wr == 0) PG8_BAR; }
    PG8_BAR;
    if constexpr (Epi::AFTER_DRAIN) { E.fused(acc, cur, wr, wc, fr, fq, lds, wid, lane); S.done(cur); }
#undef PG8_SA
#undef PG8_SB
#undef PG8_STAGE
#undef PG8_LDA
#undef PG8_LDB
#undef PG8_MMA
#undef PG8_WAIT_V
#undef PG8_WAIT_L
#undef PG8_BAR
#undef PG8_SCHED
}
}
#define LAS __attribute__((address_space(3)))
typedef unsigned short bf16_t;
typedef short bf16x8 __attribute__((ext_vector_type(8)));
typedef float f32x4 __attribute__((ext_vector_type(4)));
typedef float f32x2 __attribute__((ext_vector_type(2)));
typedef unsigned u32x4 __attribute__((ext_vector_type(4)));
typedef unsigned u32x2 __attribute__((ext_vector_type(2)));
constexpr int DM = 2048, NPR = 8192, NSM = 128, NT = 8320, MR = 8448, FF = 5504, NGU = 11008, ZW = 12288, NIN = 12544, SEQ = 2048;
constexpr float EPS = 1e-6f;
constexpr size_t MiB = 1u << 20;
constexpr size_t WS_CTL = 0, WS_W1GU = 1 * MiB, WS_W1D = 44 * MiB, WS_WIN = 66 * MiB, WS_WGLU = 115 * MiB, WS_WMEM = 117 * MiB, WS_WBR = 125 * MiB, WS_WOUT = 137 * MiB,
                 WS_W2GU = 145 * MiB, WS_W2D = 188 * MiB, WS_XB = 210 * MiB, WS_MEMB = 243 * MiB, WS_H = 247 * MiB, WS_X = 336 * MiB, WS_Z = 402 * MiB, WS_IF = 600 * MiB,
                 WS_S5Y = 601 * MiB, WS_S5O = 618 * MiB, WS_MLO = 635 * MiB, WS_XAO = 652 * MiB, WS_MLH = 669 * MiB, WS_MB = 702 * MiB, WS_MKB = 735 * MiB, WS_MVT = 737 * MiB,
                 WS_S5E = 739 * MiB, WS_S5T = 741 * MiB, WS_HSSP = 742 * MiB, WS_PART = 744 * MiB, WS_END = 752 * MiB;
constexpr size_t WS_MERGED = WS_H;
constexpr int CW_Q = 0, CW_SS1 = 1024, CW_SS2 = 9472, CW_SS3 = 17920, CW_SS4 = 26368, CW_SSM = 34816, CW_HSS = 35840, CW_END = 69632, CW_BAR = 70016;
constexpr size_t O_Y = 0, O_MK = 17039360, O_MV = 18087936, O_S5RP = 19136512, O_S5IP = 19152896, O_CP = 19169280, O_NP = 20217856, O_MP = 20221952,
                 O_S5RS = 20221968, O_S5IS = 20746256, O_CS = 21270544, O_NS = 54824976, O_MS = 54956048, O_END = 54956560;
constexpr int LDS_BYTES = 143360, LDS_MISC = 135168;
struct Args { const float* in[40]; float* out; unsigned char* ws; };
enum { I_XP = 0, I_XS, I_MEM, I_CK, I_CV, I_S5R, I_S5I, I_MC, I_MN, I_MM, I_GF1, I_W1G, I_W1U, I_W1D, I_GMIX, I_WIN, I_LRE, I_LIM, I_LSTEP, I_BRE, I_BIM, I_CRE, I_CIM, I_S5D, I_WGLU,
       I_BI, I_BF, I_GHEAD, I_GMEM, I_WMK, I_WMV, I_WBS5, I_WBML, I_WBXA, I_WOUT, I_GF2, I_W2G, I_W2U, I_W2D, I_GFIN };

__device__ __forceinline__ float bf2f(unsigned short b) { return __uint_as_float((unsigned)b << 16); }
__device__ __forceinline__ float bflo(unsigned u) { return __uint_as_float(u << 16); }
__device__ __forceinline__ float bfhi(unsigned u) { return __uint_as_float(u & 0xffff0000u); }
__device__ __forceinline__ unsigned pk2(float lo, float hi) { return pg8::cvt_pk_bf16(lo, hi); }
__device__ __forceinline__ unsigned short f2bf(float f) { return (unsigned short)(pg8::cvt_pk_bf16(f, 0.f) & 0xffffu); }
__device__ __forceinline__ float sigm(float x) { return __builtin_amdgcn_rcpf(1.0f + __expf(-x)); }
__device__ __forceinline__ float gelu_t(float x) { const float y = 0.7978845608028654f * (x + 0.044715f * x * x * x); const float t = 1.0f - 2.0f * __builtin_amdgcn_rcpf(__expf(2.0f * y) + 1.0f); return 0.5f * x * (1.0f + t); }
__device__ __forceinline__ float wave_sum(float v) {
#pragma unroll
    for (int o = 1; o < 64; o <<= 1) v += __shfl_xor(v, o);
    return v;
}
__device__ __forceinline__ float wave_max(float v) {
#pragma unroll
    for (int o = 1; o < 64; o <<= 1) v = fmaxf(v, __shfl_xor(v, o));
    return v;
}
#define LDS_WAIT() asm volatile("s_waitcnt lgkmcnt(0)" ::: "memory")
#define MFMA16(a, b, c) __builtin_amdgcn_mfma_f32_16x16x32_bf16((a), (b), (c), 0, 0, 0)

struct EpiGU {
    static constexpr bool PERM = true, AFTER_DRAIN = false;
    bf16_t* H; const float* ss; const float* ssm; float* outk; float* outv; bf16_t* MKB; bf16_t* MVT;
    __device__ __forceinline__ void operator()(const f32x4 (&acc)[2][2][4][2], const pg8::Unit& u, int wr, int wc, int fr, int fq) const {
        const int row0 = u.pm * 256 + wr * 64 + fr;
        if (u.kind == 0) {
            const int col0 = u.pn * 128 + wc * 32 + 8 * fq;
#pragma unroll
            for (int ai = 0; ai < 2; ++ai)
#pragma unroll
                for (int m = 0; m < 4; ++m) {
                    const int row = row0 + ai * 128 + m * 16; const float r = rsqrtf(ss[row] * (1.0f / DM) + EPS);
                    float hv[8];
#pragma unroll
                    for (int n = 0; n < 2; ++n)
#pragma unroll
                        for (int i = 0; i < 4; ++i) { const float g = acc[ai][0][m][n][i] * r, up = acc[ai][1][m][n][i] * r; hv[4 * n + i] = g * sigm(g) * up; }
                    u32x4 w; w.x = pk2(hv[0], hv[1]); w.y = pk2(hv[2], hv[3]); w.z = pk2(hv[4], hv[5]); w.w = pk2(hv[6], hv[7]);
                    *(u32x4*)(H + (size_t)row * FF + col0) = w;
                }
        } else {
#pragma unroll
            for (int ai = 0; ai < 2; ++ai)
#pragma unroll
                for (int m = 0; m < 4; ++m) {
                    const int row = row0 + ai * 128 + m * 16; const float r = rsqrtf(ssm[row] * (1.0f / DM) + EPS);
#pragma unroll
                    for (int bj = 0; bj < 2; ++bj) {
                        const int c = u.pn * 256 + bj * 128 + wc * 32 + 8 * fq;
                        const f32x4 v0 = acc[ai][bj][m][0] * r, v1 = acc[ai][bj][m][1] * r;
                        if (c < 1024) {
                            *(f32x4*)(outk + (size_t)row * 1024 + c) = v0; *(f32x4*)(outk + (size_t)row * 1024 + c + 4) = v1;
                            u32x4 w; w.x = pk2(v0[0], v0[1]); w.y = pk2(v0[2], v0[3]); w.z = pk2(v1[0], v1[1]); w.w = pk2(v1[2], v1[3]);
                            *(u32x4*)(MKB + (size_t)row * 1024 + c) = w;
                        } else {
                            const int cv = c - 1024;
                            *(f32x4*)(outv + (size_t)row * 1024 + cv) = v0; *(f32x4*)(outv + (size_t)row * 1024 + cv + 4) = v1;
                            const int b = row >> 8, key = row & 255, hh = cv >> 8, d = cv & 255;
                            bf16_t* vt = MVT + ((size_t)(b * 4 + hh) * 256 + d) * 256 + key;
#pragma unroll
                            for (int i = 0; i < 4; ++i) { vt[(size_t)i * 256] = f2bf(v0[i]); vt[(size_t)(i + 4) * 256] = f2bf(v1[i]); }
                        }
                    }
                }
        }
    }
};
template <int MODE>
struct EpiRes {
    static constexpr bool PERM = false, AFTER_DRAIN = false;
    const float* xp; const float* xs; float* X; bf16_t* XB; float* ss; float* PART;
    __device__ __forceinline__ void operator()(const f32x4 (&acc)[2][2][4][2], const pg8::Unit& u, int wr, int wc, int fr, int fq) const {
        const int row0 = u.pm * 256 + wr * 64 + fr, col0 = u.pn * 256 + wc * 32 + 4 * fq; const float sc = (MODE == 1) ? 1.0f : 0.5f;
        if (u.split) {
#pragma unroll
            for (int m = 0; m < 4; ++m)
#pragma unroll
                for (int bj = 0; bj < 2; ++bj)
#pragma unroll
                    for (int n = 0; n < 2; ++n) *(f32x4*)(PART + ((size_t)u.slot * 128 + wr * 64 + m * 16 + fr) * DM + col0 + bj * 128 + n * 16) = acc[0][bj][m][n];
            return;
        }
#pragma unroll
        for (int ai = 0; ai < 2; ++ai) {
            f32x4 bs[4][2][2];
#pragma unroll
            for (int m = 0; m < 4; ++m) { const int row = row0 + ai * 128 + m * 16; const float* bp = (MODE == 0) ? xp + (size_t)row * DM : X + (size_t)row * DM;
#pragma unroll
                for (int bj = 0; bj < 2; ++bj)
#pragma unroll
                    for (int n = 0; n < 2; ++n) bs[m][bj][n] = (MODE == 0) ? __builtin_nontemporal_load((const f32x4*)(bp + col0 + bj * 128 + n * 16)) : *(const f32x4*)(bp + col0 + bj * 128 + n * 16); }
#pragma unroll
            for (int m = 0; m < 4; ++m) { const int row = row0 + ai * 128 + m * 16; float sq = 0.f;
#pragma unroll
                for (int bj = 0; bj < 2; ++bj)
#pragma unroll
                    for (int n = 0; n < 2; ++n) {
                        const int c = col0 + bj * 128 + n * 16; const f32x4 v = bs[m][bj][n] + acc[ai][bj][m][n] * sc;
                        *(f32x4*)(X + (size_t)row * DM + c) = v;
                        if (MODE != 2) { u32x2 w; w.x = pk2(v[0], v[1]); w.y = pk2(v[2], v[3]); *(u32x2*)(XB + (size_t)row * DM + c) = w; }
                        sq += (v[0] * v[0] + v[1] * v[1]) + (v[2] * v[2] + v[3] * v[3]);
                    }
                sq += __shfl_xor(sq, 16); sq += __shfl_xor(sq, 32);
                if (MODE != 2 && fq == 0) atomicAdd(ss + row, sq); }
        }
    }
};
struct EpiZ {
    static constexpr bool PERM = true, AFTER_DRAIN = false;
    bf16_t* Z; float* IF; const float* ss;
    __device__ __forceinline__ void operator()(const f32x4 (&acc)[2][2][4][2], const pg8::Unit& u, int wr, int wc, int fr, int fq) const {
        const int row0 = u.pm * 256 + wr * 64 + fr;
#pragma unroll
        for (int ai = 0; ai < 2; ++ai)
#pragma unroll
            for (int m = 0; m < 4; ++m) {
                const int row = row0 + ai * 128 + m * 16; const float r = rsqrtf(ss[row] * (1.0f / DM) + EPS);
                if (u.pn < 48) {
#pragma unroll
                    for (int bj = 0; bj < 2; ++bj) {
                        const int c = u.pn * 256 + bj * 128 + wc * 32 + 8 * fq; const f32x4 v0 = acc[ai][bj][m][0] * r, v1 = acc[ai][bj][m][1] * r;
                        u32x4 w; w.x = pk2(v0[0], v0[1]); w.y = pk2(v0[2], v0[3]); w.z = pk2(v1[0], v1[1]); w.w = pk2(v1[2], v1[3]);
                        *(u32x4*)(Z + (size_t)row * ZW + c) = w;
                    }
                } else if (wc == 0 && fq == 0) {
                    *(f32x4*)(IF + (size_t)row * 8) = acc[ai][0][m][0] * r; *(f32x4*)(IF + (size_t)row * 8 + 4) = acc[ai][0][m][1] * r;
                }
            }
    }
};
struct EpiGLU {
    static constexpr bool PERM = true, AFTER_DRAIN = false;
    const bf16_t* Y; bf16_t* O;
    __device__ __forceinline__ void operator()(const f32x4 (&acc)[2][2][4][2], const pg8::Unit& u, int wr, int wc, int fr, int fq) const {
        const int row0 = u.pm * 256 + wr * 64 + fr;
#pragma unroll
        for (int ai = 0; ai < 2; ++ai)
#pragma unroll
            for (int m = 0; m < 4; ++m) {
                const int row = row0 + ai * 128 + m * 16;
#pragma unroll
                for (int bj = 0; bj < 2; ++bj) {
                    const int c = u.pn * 256 + bj * 128 + wc * 32 + 8 * fq; const u32x4 y = *(const u32x4*)(Y + (size_t)row * 1024 + c);
                    const f32x4 a0 = acc[ai][bj][m][0], a1 = acc[ai][bj][m][1];
                    u32x4 w; w.x = pk2(bflo(y.x) * sigm(a0[0]), bfhi(y.x) * sigm(a0[1])); w.y = pk2(bflo(y.y) * sigm(a0[2]), bfhi(y.y) * sigm(a0[3]));
                    w.z = pk2(bflo(y.z) * sigm(a1[0]), bfhi(y.z) * sigm(a1[1])); w.w = pk2(bflo(y.w) * sigm(a1[2]), bfhi(y.w) * sigm(a1[3]));
                    *(u32x4*)(O + (size_t)row * 1024 + c) = w;
                }
            }
    }
};
struct EpiBR {
    static constexpr bool PERM = false, AFTER_DRAIN = false;
    const bf16_t* Z; float* MG; bf16_t* MB; float* PART;
    __device__ __forceinline__ void operator()(const f32x4 (&acc)[2][2][4][2], const pg8::Unit& u, int wr, int wc, int fr, int fq) const {
        const int row0 = u.pm * 256 + wr * 64 + fr, col0 = u.pn * 256 + wc * 32 + 4 * fq;
        if (u.split) {
#pragma unroll
            for (int m = 0; m < 4; ++m) { const int r = wr * 64 + m * 16 + fr;
#pragma unroll
                for (int bj = 0; bj < 2; ++bj)
#pragma unroll
                    for (int n = 0; n < 2; ++n) { const int c = col0 + bj * 128 + n * 16; const u32x2 gz = *(const u32x2*)(Z + (size_t)(NPR + r) * ZW + 6144 + u.kind * 2048 + c);
                        const f32x4 a = acc[0][bj][m][n]; f32x4 v; v[0] = sigm(bflo(gz.x)) * a[0]; v[1] = sigm(bfhi(gz.x)) * a[1]; v[2] = sigm(bflo(gz.y)) * a[2]; v[3] = sigm(bfhi(gz.y)) * a[3];
                        *(f32x4*)(PART + ((size_t)u.slot * 128 + r) * DM + c) = v; } }
            return;
        }
#pragma unroll
        for (int ai = 0; ai < 2; ++ai)
#pragma unroll
            for (int mp = 0; mp < 2; ++mp) {
                u32x2 gzv[2][2][2]; f32x4 mgv[2][2][2];
#pragma unroll
                for (int mm = 0; mm < 2; ++mm)
#pragma unroll
                    for (int bj = 0; bj < 2; ++bj)
#pragma unroll
                        for (int n = 0; n < 2; ++n) { const int row = row0 + ai * 128 + (2 * mp + mm) * 16, c = col0 + bj * 128 + n * 16;
                            gzv[mm][bj][n] = *(const u32x2*)(Z + (size_t)row * ZW + 6144 + u.kind * 2048 + c);
                            mgv[mm][bj][n] = (f32x4){0.f, 0.f, 0.f, 0.f}; if (u.kind != 0) mgv[mm][bj][n] = *(const f32x4*)(MG + (size_t)row * DM + c); }
#pragma unroll
                for (int mm = 0; mm < 2; ++mm)
#pragma unroll
                    for (int bj = 0; bj < 2; ++bj)
#pragma unroll
                        for (int n = 0; n < 2; ++n) { const int m = 2 * mp + mm, row = row0 + ai * 128 + m * 16, c = col0 + bj * 128 + n * 16; const u32x2 gz = gzv[mm][bj][n];
                            const f32x4 a = acc[ai][bj][m][n]; f32x4 v; v[0] = sigm(bflo(gz.x)) * a[0]; v[1] = sigm(bfhi(gz.x)) * a[1]; v[2] = sigm(bflo(gz.y)) * a[2]; v[3] = sigm(bfhi(gz.y)) * a[3];
                            v = v + mgv[mm][bj][n];
                            float* mp_ = MG + (size_t)row * DM + c;
                            if (u.kind != 2) *(f32x4*)mp_ = v;
                            else { u32x2 w; w.x = pk2(v[0], v[1]); w.y = pk2(v[2], v[3]); *(u32x2*)(MB + (size_t)row * DM + c) = w; } }
            }
    }
};
__device__ __forceinline__ void tr_item(const float* W, int N, int K, const float* gain, bf16_t* WT, int k0, int nsrc0, int ndst0, LAS float* scr, int lane) {
    const int n4 = lane & 7, kq = lane >> 3;
    const float* src = W + (size_t)(k0 + 8 * kq) * N + nsrc0 + 4 * n4;
    f32x4 v[8];
#pragma unroll
    for (int j = 0; j < 8; ++j) v[j] = __builtin_nontemporal_load((const f32x4*)(src + (size_t)j * N));
    if (gain) {
        const f32x4 g0 = *(const f32x4*)(gain + k0 + 8 * kq), g1 = *(const f32x4*)(gain + k0 + 8 * kq + 4);
        v[0] = v[0] * g0[0]; v[1] = v[1] * g0[1]; v[2] = v[2] * g0[2]; v[3] = v[3] * g0[3]; v[4] = v[4] * g1[0]; v[5] = v[5] * g1[1]; v[6] = v[6] * g1[2]; v[7] = v[7] * g1[3];
    }
#pragma unroll
    for (int i = 0; i < 4; ++i) {
        u32x4 o; o.x = pk2(v[0][i], v[1][i]); o.y = pk2(v[2][i], v[3][i]); o.z = pk2(v[4][i], v[5][i]); o.w = pk2(v[6][i], v[7][i]);
        *(u32x4*)(WT + (size_t)(ndst0 + 4 * n4 + i) * K + k0 + 8 * kq) = o;
    }
}
constexpr int TRC_GU = 32 * 172, TRC_DN = 86 * 64, TRC_IN = 32 * 384, TRC_GL = 16 * 32, TRC_MK = 32 * 32, TRC_BR = 16 * 64, TRC_WO = 32 * 64;
constexpr int TR_NITEMS = 4 * TRC_GU + 2 * TRC_DN + TRC_IN + TRC_GL + 2 * TRC_MK + 3 * TRC_BR + TRC_WO;
__device__ __forceinline__ void tr_dispatch(const Args& a, int it, int lane) {
    unsigned char* ws = a.ws; LAS float* scr = nullptr;
    constexpr int C_GU = 32 * 172, C_DN = 86 * 64, C_IN = 32 * 384, C_GL = 16 * 32, C_MK = 32 * 32, C_BR = 16 * 64, C_WO = 32 * 64;
        int r = it;
        if (r < 4 * C_GU) { const int q = r / C_GU; r -= q * C_GU; const int kb = r / 172, nb = r % 172, ns = 32 * nb, nd = (ns >> 7) * 256 + (ns & 127) + ((q & 1) ? 128 : 0);
            tr_item(a.in[q == 0 ? I_W1G : (q == 1 ? I_W1U : (q == 2 ? I_W2G : I_W2U))], FF, DM, a.in[q < 2 ? I_GF1 : I_GF2], (bf16_t*)(ws + (q < 2 ? WS_W1GU : WS_W2GU)), 64 * kb, ns, nd, scr, lane); return; }
        r -= 4 * C_GU;
        if (r < 2 * C_DN) { const int q = r / C_DN; r -= q * C_DN; const int kb = r / 64, nb = r % 64;
            tr_item(a.in[q == 0 ? I_W1D : I_W2D], DM, FF, nullptr, (bf16_t*)(ws + (q == 0 ? WS_W1D : WS_W2D)), 64 * kb, 32 * nb, 32 * nb, scr, lane); return; }
        r -= 2 * C_DN;
        if (r < C_IN) { const int kb = r / 384, nb = r % 384, nd = 32 * nb, ns = nd + (nd >= 5120 ? 8 : 0);
            tr_item(a.in[I_WIN], 12296, DM, a.in[I_GMIX], (bf16_t*)(ws + WS_WIN), 64 * kb, ns, nd, scr, lane); return; }
        r -= C_IN;
        if (r < C_GL) { const int kb = r / 32, nb = r % 32; tr_item(a.in[I_WGLU], 1024, 1024, nullptr, (bf16_t*)(ws + WS_WGLU), 64 * kb, 32 * nb, 32 * nb, scr, lane); return; }
        r -= C_GL;
        if (r < 2 * C_MK) { const int q = r / C_MK; r -= q * C_MK; const int kb = r / 32, nb = r % 32;
            tr_item(a.in[q == 0 ? I_WMK : I_WMV], 1024, DM, a.in[I_GMEM], (bf16_t*)(ws + WS_WMEM), 64 * kb, 32 * nb, 1024 * q + 32 * nb, scr, lane); return; }
        r -= 2 * C_MK;
        if (r < 3 * C_BR) { const int q = r / C_BR; r -= q * C_BR; const int kb = r / 64, nb = r % 64;
            tr_item(a.in[q == 0 ? I_WBS5 : (q == 1 ? I_WBML : I_WBXA)], DM, 1024, nullptr, (bf16_t*)(ws + WS_WBR) + (size_t)q * DM * 1024, 64 * kb, 32 * nb, 32 * nb, scr, lane); return; }
        r -= 3 * C_BR;
        { const int kb = r / 64, nb = r % 64; tr_item(a.in[I_WOUT], DM, DM, nullptr, (bf16_t*)(ws + WS_WOUT), 64 * kb, 32 * nb, 32 * nb, scr, lane); }
}
__device__ __forceinline__ double dexp_small(double x) {
    double s = 1.0;
#pragma unroll
    for (int i = 16; i >= 1; --i) s = 1.0 + s * x * (1.0 / (double)i);
    return s;
}
__device__ __forceinline__ void p0_prologue(const Args& a, LAS unsigned char* lds) {
    const int tid = pg8::opaque_tid(), lane = tid & 63, wave = tid >> 6, G = gridDim.x;
    const int gw = blockIdx.x * 8 + wave, NGW = G * 8;
    unsigned char* ws = a.ws;
    LAS float* scr = (LAS float*)(lds + wave * 16384);
    { unsigned* ctl = (unsigned*)(ws + WS_CTL); const int gt = blockIdx.x * 512 + tid, NG = G * 512;
      for (int i = gt; i < 64; i += NG) ctl[CW_Q + i] = 0u;
      for (int i = CW_SS2 + gt; i < CW_SSM; i += NG) ctl[i] = 0u;
      for (int i = CW_HSS + gt; i < CW_END; i += NG) ctl[i] = 0u;
      bf16_t* WINp = (bf16_t*)(ws + WS_WIN) + (size_t)ZW * DM; const float* win = a.in[I_WIN]; const float* gm = a.in[I_GMIX];
      for (int i = gt; i < 256 * DM; i += NG) { const int j = i >> 11, k = i & 2047; WINp[i] = (j < 8) ? f2bf(win[(size_t)k * 12296 + 5120 + j] * gm[k]) : (bf16_t)0; }
      float* AB = (float*)(ws + WS_S5T); bf16_t* BBt = (bf16_t*)(ws + WS_S5T + 32768);
      for (int i = gt; i < 4096; i += NG) {
          const int g = i >> 6;
          const double lr = (double)a.in[I_LRE][i], li = (double)a.in[I_LIM][i], ls = (double)a.in[I_LSTEP][g];
          double dt = dexp_small(ls * (1.0 / 16.0)); dt *= dt; dt *= dt; dt *= dt; dt *= dt;
          const double mag = dexp_small(lr * dt);
          double th = li * dt; th -= 6.283185307179586476925 * rint(th * 0.15915494309189533577); const double hh = 0.5 * th, h2 = hh * hh;
          double sn = 1.0, cs = 1.0;
#pragma unroll
          for (int k = 10; k >= 1; --k) { sn = 1.0 - sn * h2 * (1.0 / (double)((2 * k) * (2 * k + 1))); cs = 1.0 - cs * h2 * (1.0 / (double)((2 * k - 1) * (2 * k))); }
          sn *= hh;
          const double sinT = 2.0 * sn * cs, cosT = 1.0 - 2.0 * sn * sn;
          const double abr = mag * cosT, abi = mag * sinT, den = lr * lr + li * li, nr = abr - 1.0;
          const double zr = (nr * lr + abi * li) / den, zi = (abi * lr - nr * li) / den;
          AB[2 * i] = (float)abr; AB[2 * i + 1] = (float)abi;
          const int p = i & 63;
#pragma unroll
          for (int h = 0; h < 16; ++h) { const double br = (double)a.in[I_BRE][(size_t)i * 16 + h], bi = (double)a.in[I_BIM][(size_t)i * 16 + h];
              BBt[((size_t)g * 128 + p) * 16 + h] = f2bf((float)(zr * br - zi * bi)); BBt[((size_t)g * 128 + 64 + p) * 16 + h] = f2bf((float)(zr * bi + zi * br)); }
      }
    }
    for (int it = gw; it < 2 * TRC_GU; it += NGW) tr_dispatch(a, it, lane);
    for (int it = 4 * TRC_GU + 2 * TRC_DN + TRC_IN + TRC_GL + gw; it < 4 * TRC_GU + 2 * TRC_DN + TRC_IN + TRC_GL + 2 * TRC_MK; it += NGW) tr_dispatch(a, it, lane);
    { bf16_t* XB = (bf16_t*)(ws + WS_XB); bf16_t* MEMB = (bf16_t*)(ws + WS_MEMB); float* ctlf = (float*)(ws + WS_CTL);
      for (int row = gw; row < MR + 1024; row += NGW) {
          const float* src; bf16_t* dst; float* sd;
          if (row < MR) { src = row < NPR ? a.in[I_XP] + (size_t)row * DM : a.in[I_XS] + (size_t)(row - NPR) * DM; dst = XB + (size_t)row * DM; sd = ctlf + CW_SS1 + row; }
          else { const int mr = row - MR; src = a.in[I_MEM] + (size_t)mr * DM; dst = MEMB + (size_t)mr * DM; sd = ctlf + CW_SSM + mr; }
          const bool real = (row < NT) || (row >= MR);
          float s = 0.f;
#pragma unroll
          for (int j = 0; j < 8; ++j) { f32x4 v = (f32x4){0.f, 0.f, 0.f, 0.f}; if (real) v = *(const f32x4*)(src + 4 * (lane + 64 * j));
              s += (v[0] * v[0] + v[1] * v[1]) + (v[2] * v[2] + v[3] * v[3]); u32x2 w; w.x = pk2(v[0], v[1]); w.y = pk2(v[2], v[3]); *(u32x2*)(dst + 4 * (lane + 64 * j)) = w; }
          s = wave_sum(s); if (lane == 0) *sd = s;
      }
    }
}
template <int MODE>
__device__ __forceinline__ void s5_wave(const Args& a, LAS unsigned char* wl, int item, int lane) {
    unsigned char* ws = a.ws;
    const bf16_t* Z = (const bf16_t*)(ws + WS_Z); bf16_t* S5Y = (bf16_t*)(ws + WS_S5Y); float* S5E = (float*)(ws + WS_S5E);
    const float* AB = (const float*)(ws + WS_S5T); const bf16_t* BBt = (const bf16_t*)(ws + WS_S5T + 32768);
    int b, g, ch = 0, nblk; size_t tok0;
    { const int it = item >> 3, w8 = item & 7, gl = w8 & 3, cl = w8 >> 2;
      if (MODE == 2) { g = 4 * (it & 15) + gl; b = 2 * (it >> 4) + cl; tok0 = (size_t)NPR + b; nblk = 1; }
      else { b = it >> 7; g = 4 * ((it & 127) >> 3) + gl; ch = 2 * (it & 7) + cl; tok0 = (size_t)b * SEQ + ch * 128; nblk = 8; } }
    const int p = lane, r16 = lane & 15, g4 = lane >> 4;
    LAS float* BU = (LAS float*)wl;
    LAS bf16_t* SB = (LAS bf16_t*)(wl + 8448);
    LAS bf16_t* UB = (LAS bf16_t*)(wl + 12800);
    const float ar = AB[(g * 64 + p) * 2], ai = AB[(g * 64 + p) * 2 + 1];
    bf16x8 bb[8];
#pragma unroll
    for (int T = 0; T < 8; ++T) { bb[T] = (bf16x8){0, 0, 0, 0, 0, 0, 0, 0}; if (g4 < 2) bb[T] = *(const bf16x8*)(BBt + ((size_t)g * 128 + 16 * T + r16) * 16 + 8 * g4); }
    bf16x8 cc[4]; float dco = 0.f;
    if (MODE != 0) {
        dco = a.in[I_S5D][g * 16 + r16];
#pragma unroll
        for (int ks = 0; ks < 4; ++ks) { const int k0 = 32 * ks + 8 * g4; const bool im = k0 >= 64;
            const float* cp = (im ? a.in[I_CIM] : a.in[I_CRE]) + ((size_t)g * 16 + r16) * 64 + (im ? k0 - 64 : k0);
            const f32x4 c0 = *(const f32x4*)cp, c1 = *(const f32x4*)(cp + 4); const float sg = im ? -1.f : 1.f;
            u32x4 w; w.x = pk2(sg * c0[0], sg * c0[1]); w.y = pk2(sg * c0[2], sg * c0[3]); w.z = pk2(sg * c1[0], sg * c1[1]); w.w = pk2(sg * c1[2], sg * c1[3]);
            cc[ks] = __builtin_bit_cast(bf16x8, w); }
    }
    float sr = 0.f, si = 0.f;
    if (MODE == 1 && ch > 0) {
        float pr = ar, pi = ai;
#pragma unroll
        for (int i = 0; i < 7; ++i) { const float t = pr * pr - pi * pi; pi = 2.f * pr * pi; pr = t; }
        float erv[15], eiv[15];
#pragma unroll
        for (int j = 0; j < 15; ++j) { erv[j] = 0.f; eiv[j] = 0.f; if (j < ch) { const float* e = S5E + ((size_t)(b * 64 + g) * 16 + j) * 128; erv[j] = e[p]; eiv[j] = e[64 + p]; } }
#pragma unroll
        for (int j = 0; j < 15; ++j) if (j < ch) { const float t = pr * sr - pi * si + erv[j]; si = pr * si + pi * sr + eiv[j]; sr = t; }
    }
    if (MODE == 2) { sr = a.in[I_S5R][(size_t)(b * 64 + g) * 64 + p]; si = a.in[I_S5I][(size_t)(b * 64 + g) * 64 + p]; }
    bf16x8 un = (bf16x8){0, 0, 0, 0, 0, 0, 0, 0};
    if (g4 < 2 && (MODE != 2 || r16 == 0)) un = *(const bf16x8*)(Z + (tok0 + r16) * ZW + g * 16 + 8 * g4);
    for (int blk = 0; blk < nblk; ++blk) {
        const size_t t0 = tok0 + 16 * blk;
        const bf16x8 ua = un;
        if (MODE != 0 && g4 < 2) *(LAS bf16x8*)(UB + r16 * 16 + 8 * g4) = ua;
        if (MODE != 2 && blk + 1 < nblk && g4 < 2) un = *(const bf16x8*)(Z + (t0 + 16 + r16) * ZW + g * 16 + 8 * g4);
#pragma unroll
        for (int T = 0; T < 8; ++T) { const f32x4 d = MFMA16(ua, bb[T], ((f32x4){0.f, 0.f, 0.f, 0.f}));
#pragma unroll
            for (int r = 0; r < 4; ++r) BU[(4 * g4 + r) * 132 + 16 * T + r16] = d[r]; }
        LDS_WAIT(); asm volatile("" ::: "memory");
        float brv[16], biv[16];
#pragma unroll
        for (int t = 0; t < 16; ++t) { if (MODE == 2 && t > 0) break; brv[t] = BU[t * 132 + p]; biv[t] = BU[t * 132 + 64 + p]; }
#pragma unroll
        for (int t = 0; t < 16; ++t) {
            if (MODE == 2 && t > 0) break;
            const float br = brv[t], bi = biv[t];
            const float nr = ar * sr - ai * si + br; si = ar * si + ai * sr + bi; sr = nr;
            if (MODE != 0) { SB[t * 136 + p] = f2bf(sr); SB[t * 136 + 64 + p] = f2bf(si); }
        }
        LDS_WAIT(); asm volatile("" ::: "memory");
        if (MODE != 0) {
            f32x4 y = (f32x4){0.f, 0.f, 0.f, 0.f};
#pragma unroll
            for (int ks = 0; ks < 4; ++ks) { const bf16x8 af = *(const LAS bf16x8*)(SB + r16 * 136 + 32 * ks + 8 * g4); y = MFMA16(af, cc[ks], y); }
#pragma unroll
            for (int r = 0; r < 4; ++r) { const int t = 4 * g4 + r;
                if (MODE != 2 || t == 0) { const float uu = bf2f(UB[t * 16 + r16]); S5Y[(t0 + t) * 1024 + g * 16 + r16] = f2bf(gelu_t(y[r] + dco * uu)); } }
            LDS_WAIT(); asm volatile("" ::: "memory");
        }
    }
    if (MODE == 0) { float* e = S5E + ((size_t)(b * 64 + g) * 16 + ch) * 128; e[p] = sr; e[64 + p] = si; }
    if (MODE == 1 && ch == 15) { a.out[O_S5RP + (size_t)(b * 64 + g) * 64 + p] = sr; a.out[O_S5IP + (size_t)(b * 64 + g) * 64 + p] = si; }
    if (MODE == 2) { a.out[O_S5RS + (size_t)(b * 64 + g) * 64 + p] = sr; a.out[O_S5IS + (size_t)(b * 64 + g) * 64 + p] = si; }
}

__device__ __forceinline__ void xatt_prompt(const Args& a, LAS unsigned char* lds, int item) {
    unsigned char* ws = a.ws;
    const bf16_t* Z = (const bf16_t*)(ws + WS_Z); const bf16_t* MKB = (const bf16_t*)(ws + WS_MKB); const bf16_t* MVT = (const bf16_t*)(ws + WS_MVT); bf16_t* XAO = (bf16_t*)(ws + WS_XAO);
    const int tid = pg8::opaque_tid(), lane = tid & 63, w = tid >> 6, r16 = lane & 15, g4 = lane >> 4;
    const int b = item >> 6, h = (item >> 4) & 3, qb = item & 15;
    const size_t tokw = (size_t)b * SEQ + qb * 128 + w * 16;
    LAS bf16_t* Pw = (LAS bf16_t*)(lds + w * 8448);
    bf16x8 qf[8];
#pragma unroll
    for (int ks = 0; ks < 8; ++ks) qf[ks] = *(const bf16x8*)(Z + (tokw + r16) * ZW + 5120 + h * 256 + 32 * ks + 8 * g4);
    f32x4 s[16];
#pragma unroll
    for (int kt = 0; kt < 16; ++kt) { s[kt] = (f32x4){0.f, 0.f, 0.f, 0.f};
        const bf16_t* kp = MKB + ((size_t)(b * 256 + 16 * kt + r16)) * 1024 + h * 256 + 8 * g4;
#pragma unroll
        for (int ks = 0; ks < 8; ++ks) s[kt] = MFMA16(qf[ks], *(const bf16x8*)(kp + 32 * ks), s[kt]); }
    float rs[4];
#pragma unroll
    for (int r = 0; r < 4; ++r) {
        float mx = s[0][r];
#pragma unroll
        for (int kt = 1; kt < 16; ++kt) mx = fmaxf(mx, s[kt][r]);
        mx = fmaxf(mx, __shfl_xor(mx, 1)); mx = fmaxf(mx, __shfl_xor(mx, 2)); mx = fmaxf(mx, __shfl_xor(mx, 4)); mx = fmaxf(mx, __shfl_xor(mx, 8));
        float sm = 0.f;
#pragma unroll
        for (int kt = 0; kt < 16; ++kt) { const float e = __expf((s[kt][r] - mx) * 0.0625f); sm += e; Pw[(4 * g4 + r) * 264 + 16 * kt + r16] = f2bf(e); }
        sm += __shfl_xor(sm, 1); sm += __shfl_xor(sm, 2); sm += __shfl_xor(sm, 4); sm += __shfl_xor(sm, 8);
        rs[r] = 1.0f / sm;
    }
    LDS_WAIT(); asm volatile("" ::: "memory");
    bf16x8 pf[8];
#pragma unroll
    for (int ks = 0; ks < 8; ++ks) pf[ks] = *(const LAS bf16x8*)(Pw + r16 * 264 + 32 * ks + 8 * g4);
#pragma unroll 4
    for (int dt = 0; dt < 16; ++dt) { f32x4 o = (f32x4){0.f, 0.f, 0.f, 0.f};
        const bf16_t* vp = MVT + ((size_t)((b * 4 + h) * 256 + 16 * dt + r16)) * 256 + 8 * g4;
#pragma unroll
        for (int ks = 0; ks < 8; ++ks) o = MFMA16(pf[ks], *(const bf16x8*)(vp + 32 * ks), o);
#pragma unroll
        for (int r = 0; r < 4; ++r) XAO[(tokw + 4 * g4 + r) * 1024 + h * 256 + 16 * dt + r16] = f2bf(o[r] * rs[r]); }
    LDS_WAIT(); asm volatile("" ::: "memory");
}

__device__ __forceinline__ void xatt_sample(const Args& a, LAS unsigned char* lds, int item) {
    unsigned char* ws = a.ws;
    const bf16_t* Z = (const bf16_t*)(ws + WS_Z); bf16_t* XAO = (bf16_t*)(ws + WS_XAO);
    const int tid = pg8::opaque_tid(), lane = tid & 63, w = tid >> 6;
    const int b = item >> 2, h = item & 3; const size_t tok = (size_t)NPR + b;
    LAS float* sc = (LAS float*)lds; LAS float* pl = sc + 256; LAS float* part = sc + 512;
    const u32x2 qz = *(const u32x2*)(Z + tok * ZW + 5120 + h * 256 + 4 * lane);
    const float q0 = bflo(qz.x) * 0.0625f, q1 = bfhi(qz.x) * 0.0625f, q2 = bflo(qz.y) * 0.0625f, q3 = bfhi(qz.y) * 0.0625f;
    const float* Kc = a.in[I_CK] + ((size_t)b * 256 * 4 + h) * 256 + 4 * lane;
    const float* Vc = a.in[I_CV] + ((size_t)b * 256 * 4 + h) * 256 + 4 * lane;
    float myscore = 0.f;
#pragma unroll 8
    for (int kk = 0; kk < 32; ++kk) { const f32x4 kv = __builtin_nontemporal_load((const f32x4*)(Kc + (size_t)(32 * w + kk) * 1024));
        float d = (q0 * kv[0] + q1 * kv[1]) + (q2 * kv[2] + q3 * kv[3]); d = wave_sum(d); if (lane == kk) myscore = d; }
    if (lane < 32) sc[32 * w + lane] = myscore;
    __syncthreads();
    { const float v0 = sc[lane], v1 = sc[lane + 64], v2 = sc[lane + 128], v3 = sc[lane + 192];
      const float mx = wave_max(fmaxf(fmaxf(v0, v1), fmaxf(v2, v3)));
      const float e0 = __expf(v0 - mx), e1 = __expf(v1 - mx), e2 = __expf(v2 - mx), e3 = __expf(v3 - mx);
      const float inv = 1.0f / wave_sum((e0 + e1) + (e2 + e3));
      if (w == 0) { pl[lane] = e0 * inv; pl[lane + 64] = e1 * inv; pl[lane + 128] = e2 * inv; pl[lane + 192] = e3 * inv; } }
    __syncthreads();
    f32x4 acc = (f32x4){0.f, 0.f, 0.f, 0.f};
#pragma unroll 8
    for (int kk = 0; kk < 32; ++kk) { const f32x4 vv = __builtin_nontemporal_load((const f32x4*)(Vc + (size_t)(32 * w + kk) * 1024)); acc = acc + vv * pl[32 * w + kk]; }
    *(LAS f32x4*)(part + w * 256 + 4 * lane) = acc;
    __syncthreads();
    if (tid < 256) { float o = 0.f;
#pragma unroll
        for (int i = 0; i < 8; ++i) o += part[i * 256 + tid];
        XAO[tok * 1024 + h * 256 + tid] = f2bf(o); }
}

__device__ __forceinline__ float logsig(float x) { return fminf(x, 0.f) - __logf(1.0f + __expf(-fabsf(x))); }
__device__ __forceinline__ void mlstm_sample(const Args& a, LAS unsigned char* lds, int item) {
    unsigned char* ws = a.ws;
    const bf16_t* Z = (const bf16_t*)(ws + WS_Z); const float* IF = (const float*)(ws + WS_IF); bf16_t* MLO = (bf16_t*)(ws + WS_MLO);
    const int tid = pg8::opaque_tid(), lane = tid & 63, w = tid >> 6;
    const int b = item >> 2, h = item & 3; const size_t tok = (size_t)NPR + b; const size_t bh = (size_t)b * 4 + h;
    LAS float* qs = (LAS float*)lds; LAS float* ks = qs + 256; LAS float* vs = qs + 512; LAS float* part = qs + 768; LAS float* red = qs + 768 + 2048;
    if (tid < 256) { qs[tid] = bf2f(Z[tok * ZW + 1024 + h * 256 + tid]); ks[tid] = bf2f(Z[tok * ZW + 2048 + h * 256 + tid]) * 0.0625f; vs[tid] = bf2f(Z[tok * ZW + 3072 + h * 256 + tid]); }
    const float ipre = IF[tok * 8 + h] + a.in[I_BI][h], fpre = IF[tok * 8 + 4 + h] + a.in[I_BF][h];
    const float m0 = a.in[I_MM][bh], gi = logsig(fpre) + m0, mt = fmaxf(gi, ipre), wi = __expf(gi - mt), wa = __expf(ipre - mt);
    const float* n0 = a.in[I_MN] + bh * 256;
    __syncthreads();
    float qk, qn;
    { const f32x4 q4 = *(const LAS f32x4*)(qs + 4 * lane), k4 = *(const LAS f32x4*)(ks + 4 * lane), n4 = *(const f32x4*)(n0 + 4 * lane);
      qk = wave_sum((q4[0] * k4[0] + q4[1] * k4[1]) + (q4[2] * k4[2] + q4[3] * k4[3])); qn = wave_sum((q4[0] * n4[0] + q4[1] * n4[1]) + (q4[2] * n4[2] + q4[3] * n4[3])); }
    const float sv = qk * wa;
    const f32x4 vv = *(const LAS f32x4*)(vs + 4 * lane);
    const float* C0 = a.in[I_MC] + bh * 65536 + 4 * lane; float* C1 = a.out + O_CS + bh * 65536 + 4 * lane;
    f32x4 acc = (f32x4){0.f, 0.f, 0.f, 0.f};
#pragma unroll 8
    for (int r = 0; r < 32; ++r) { const int dk = 32 * w + r; const f32x4 c = __builtin_nontemporal_load((const f32x4*)(C0 + (size_t)dk * 256)); const float qd = qs[dk], kd = ks[dk] * wa;
        acc = acc + c * qd; __builtin_nontemporal_store(c * wi + vv * kd, (f32x4*)(C1 + (size_t)dk * 256)); }
    *(LAS f32x4*)(part + w * 256 + 4 * lane) = acc;
    __syncthreads();
    float hval = 0.f;
    if (tid < 256) { float qc = 0.f;
#pragma unroll
        for (int i = 0; i < 8; ++i) qc += part[i * 256 + tid];
        const float num = sv * vs[tid] + wi * qc, nq = sv + wi * qn, den = fmaxf(fabsf(nq), __expf(-mt));
        hval = num / den;
        a.out[O_NS + bh * 256 + tid] = wi * n0[tid] + wa * ks[tid];
        if (tid == 0) a.out[O_MS + bh] = mt; }
    const float sq = wave_sum(hval * hval); if (lane == 0) red[w] = sq;
    __syncthreads();
    if (tid < 256) { const float ssq = (red[0] + red[1]) + (red[2] + red[3]); const float rstd = rsqrtf(ssq * (1.0f / 256.0f) + EPS);
        const float o = bf2f(Z[tok * ZW + 4096 + h * 256 + tid]);
        MLO[tok * 1024 + h * 256 + tid] = f2bf(hval * rstd * a.in[I_GHEAD][h * 256 + tid] * sigm(o)); }
}
__device__ __forceinline__ void mlstm_prompt(const Args& a, LAS unsigned char* L, int item) {
    unsigned char* ws = a.ws;
    const bf16_t* Z = (const bf16_t*)(ws + WS_Z); const float* IF = (const float*)(ws + WS_IF); float* MLH = (float*)(ws + WS_MLH); float* HSSP = (float*)(ws + WS_HSSP);
    const int tid = pg8::opaque_tid(), lane = tid & 63, w = tid >> 6, r16 = lane & 15, g4 = lane >> 4;
    const int b = item >> 5, h = (item >> 3) & 3, j = item & 7;
    LAS bf16_t* Ks = (LAS bf16_t*)L; LAS bf16_t* Vt = (LAS bf16_t*)(L + 33792); LAS bf16_t* VtW = (LAS bf16_t*)(L + 40704); LAS bf16_t* Ct = (LAS bf16_t*)(L + 47616);
    LAS bf16_t* Ss = (LAS bf16_t*)(L + 72960); LAS float* NQ = (LAS float*)(L + 85248); LAS float* GA = (LAS float*)(L + 85504);
    const size_t tokb = (size_t)b * SEQ;
    const bf16_t* Zq = Z + 1024 + h * 256; const bf16_t* Zk = Z + 2048 + h * 256; const bf16_t* Zv = Z + 3072 + h * 256 + 32 * j;
    const int tr = w >> 1, tcv = w & 1; const bool ones = (w & 1) == 0;
    for (int i = tid; i < 48 * 264 / 2; i += 512) ((LAS unsigned*)Ct)[i] = 0u;
    for (int i = tid; i < 16 * 72; i += 512) { Vt[32 * 72 + i] = (i < 72) ? (bf16_t)0x3F80 : (bf16_t)0; VtW[32 * 72 + i] = 0; }
    f32x4 Cacc[2][3];
#pragma unroll
    for (int i = 0; i < 2; ++i)
#pragma unroll
        for (int c = 0; c < 3; ++c) Cacc[i][c] = (f32x4){0.f, 0.f, 0.f, 0.f};
    u32x4 kreg[4]; u32x4 vreg = (u32x4){0u, 0u, 0u, 0u}; bf16x8 qf[8];
    const float bi_h = a.in[I_BI][h], bf_h = a.in[I_BF][h];
#define ML_LOADKV(c) do { const size_t t0_ = tokb + 64 * (c); \
        _Pragma("unroll") for (int i_ = 0; i_ < 4; ++i_) { const int pp = tid + 512 * i_; kreg[i_] = *(const u32x4*)(Zk + (t0_ + (pp >> 5)) * ZW + 8 * (pp & 31)); } \
        if (tid < 256) vreg = *(const u32x4*)(Zv + (t0_ + (tid >> 2)) * ZW + 8 * (tid & 3)); } while (0)
#define ML_LOADQ(c) do { const size_t t0_ = tokb + 64 * (c) + 16 * tr + r16; \
        _Pragma("unroll") for (int ks_ = 0; ks_ < 8; ++ks_) qf[ks_] = *(const bf16x8*)(Zq + t0_ * ZW + 32 * ks_ + 8 * g4); } while (0)
    ML_LOADKV(0); ML_LOADQ(0);
#pragma unroll 1
    for (int cc = w; cc < 32; cc += 8) { LAS float* Gc = GA + cc * 384; const size_t t_ = tokb + 64 * cc + lane;
        float bc = logsig(IF[t_ * 8 + 4 + h] + bf_h); const float ipre = IF[t_ * 8 + h] + bi_h;
#pragma unroll
        for (int o = 1; o < 64; o <<= 1) { const float t = __shfl_up(bc, o); if (lane >= o) bc += t; }
        const float av = ipre - bc; float am = av;
#pragma unroll
        for (int o = 1; o < 64; o <<= 1) { const float t = __shfl_up(am, o); if (lane >= o) am = fmaxf(am, t); }
        Gc[lane] = bc; Gc[64 + lane] = av; Gc[128 + lane] = am; if (lane == 63) { Gc[320] = bc; Gc[321] = am; } }
    __syncthreads();
    if (tid == 0) { float m = 0.f;
        for (int cc = 0; cc < 32; ++cc) { LAS float* Gc = GA + cc * 384; const float B = Gc[320], AM = Gc[321]; Gc[322] = m; m = fmaxf(B + m, B + AM); }
        GA[323] = m; }
    __syncthreads();
#pragma unroll 1
    for (int cc = w; cc < 32; cc += 8) { LAS float* Gc = GA + cc * 384;
        const float bc = Gc[lane], av = Gc[64 + lane], am = Gc[128 + lane], B63 = Gc[320], AM63 = Gc[321], mp = Gc[322];
        const float gi = bc + mp, mt = fmaxf(gi, bc + am), mt63 = fmaxf(B63 + mp, B63 + AM63);
        Gc[lane] = bc - mt; Gc[128 + lane] = __expf(gi - mt); Gc[192 + lane] = __expf(B63 + av - mt63) * 0.0625f; Gc[256 + lane] = __expf(-mt);
        if (lane == 0) Gc[320] = __expf(B63 + mp - mt63); }
    __syncthreads();
    for (int c = 0; c < 32; ++c) {
        const LAS float* Gc = GA + c * 384;
#pragma unroll
        for (int i = 0; i < 4; ++i) { const int pp = tid + 512 * i; *(LAS u32x4*)(Ks + (pp >> 5) * 264 + 8 * (pp & 31)) = kreg[i]; }
        if (tid < 256) { const int s = tid >> 2, vq = tid & 3; const float wl = Gc[192 + s];
            const unsigned vw[4] = {vreg.x, vreg.y, vreg.z, vreg.w};
#pragma unroll
            for (int e = 0; e < 4; ++e) { const unsigned short lo = (unsigned short)(vw[e] & 0xffffu), hi = (unsigned short)(vw[e] >> 16);
                Vt[(8 * vq + 2 * e) * 72 + s] = lo; Vt[(8 * vq + 2 * e + 1) * 72 + s] = hi;
                VtW[(8 * vq + 2 * e) * 72 + s] = f2bf(bf2f(lo) * wl * 16.0f * 0.0625f); VtW[(8 * vq + 2 * e + 1) * 72 + s] = f2bf(bf2f(hi) * wl * 16.0f * 0.0625f); } }
        if (tid < 64) VtW[32 * 72 + tid] = f2bf(Gc[192 + tid]);
        if (c + 1 < 32) ML_LOADKV(c + 1);
        __syncthreads();
#pragma unroll
        for (int tt = 0; tt < 2; ++tt) { const int tc = 2 * (w & 1) + tt; f32x4 sacc = (f32x4){0.f, 0.f, 0.f, 0.f};
#pragma unroll
            for (int ks = 0; ks < 8; ++ks) sacc = MFMA16(qf[ks], *(const LAS bf16x8*)(Ks + (16 * tc + r16) * 264 + 32 * ks + 8 * g4), sacc);
            const int s = 16 * tc + r16; const float ga = Gc[64 + s];
#pragma unroll
            for (int r = 0; r < 4; ++r) { const int t = 16 * tr + 4 * g4 + r; const float wgt = (s <= t) ? __expf(Gc[t] + ga) * 0.0625f : 0.f; Ss[t * 72 + s] = f2bf(sacc[r] * wgt); } }
        f32x4 oacc[2];
#pragma unroll
        for (int q = 0; q < 2; ++q) { oacc[q] = (f32x4){0.f, 0.f, 0.f, 0.f};
            if (q == 0 || ones) { const int ct = (q == 0) ? tcv : 2;
#pragma unroll
                for (int ks = 0; ks < 8; ++ks) oacc[q] = MFMA16(qf[ks], *(const LAS bf16x8*)(Ct + (16 * ct + r16) * 264 + 32 * ks + 8 * g4), oacc[q]);
#pragma unroll
                for (int r = 0; r < 4; ++r) oacc[q][r] *= Gc[128 + 16 * tr + 4 * g4 + r]; } }
        if (c + 1 < 32) ML_LOADQ(c + 1);
        __syncthreads();
#pragma unroll
        for (int q = 0; q < 2; ++q) if (q == 0 || ones) { const int ct = (q == 0) ? tcv : 2;
#pragma unroll
            for (int ks = 0; ks < 2; ++ks) oacc[q] = MFMA16(*(const LAS bf16x8*)(Ss + (16 * tr + r16) * 72 + 32 * ks + 8 * g4), *(const LAS bf16x8*)(Vt + (16 * ct + r16) * 72 + 32 * ks + 8 * g4), oacc[q]); }
        if (ones && r16 == 0) {
#pragma unroll
            for (int r = 0; r < 4; ++r) NQ[16 * tr + 4 * g4 + r] = oacc[1][r]; }
        { const float wC = Gc[320];
#pragma unroll
          for (int i = 0; i < 2; ++i) { const int db = 2 * w + i;
              bf16x8 af[2];
#pragma unroll
              for (int ks = 0; ks < 2; ++ks) { bf16x8 t;
#pragma unroll
                  for (int e = 0; e < 8; ++e) t[e] = (short)Ks[(32 * ks + 8 * g4 + e) * 264 + 16 * db + r16];
                  af[ks] = t; }
#pragma unroll
              for (int ct = 0; ct < 3; ++ct) { f32x4 cv = Cacc[i][ct] * wC;
#pragma unroll
                  for (int ks = 0; ks < 2; ++ks) cv = MFMA16(af[ks], *(const LAS bf16x8*)(VtW + (16 * ct + r16) * 72 + 32 * ks + 8 * g4), cv);
                  Cacc[i][ct] = cv;
                  u32x2 wv; wv.x = pk2(cv[0], cv[1]); wv.y = pk2(cv[2], cv[3]); *(LAS u32x2*)(Ct + (16 * ct + r16) * 264 + 16 * db + 4 * g4) = wv; } } }
        __syncthreads();
        { float* op = MLH + (tokb + 64 * c + 16 * tr + 4 * g4) * 1024 + h * 256 + 32 * j + 16 * tcv + r16;
#pragma unroll
          for (int r = 0; r < 4; ++r) { const int t = 16 * tr + 4 * g4 + r; const float hv = oacc[0][r] / fmaxf(fabsf(NQ[t]), Gc[256 + t]); op[(size_t)r * 1024] = hv;
              float sq = hv * hv; sq += __shfl_xor(sq, 1); sq += __shfl_xor(sq, 2); sq += __shfl_xor(sq, 4); sq += __shfl_xor(sq, 8);
              if (r16 == 0) HSSP[((size_t)(2 * j + tcv) * 4 + h) * NPR + tokb + 64 * c + t] = sq; } }
    }
    { float* Cp = a.out + O_CP + ((size_t)(b * 4 + h) * 256) * 256 + 32 * j;
#pragma unroll
      for (int i = 0; i < 2; ++i)
#pragma unroll
          for (int r = 0; r < 4; ++r) { const int d = 16 * (2 * w + i) + 4 * g4 + r;
              Cp[(size_t)d * 256 + r16] = Cacc[i][0][r]; Cp[(size_t)d * 256 + 16 + r16] = Cacc[i][1][r];
              if (j == 0 && r16 == 0) a.out[O_NP + (size_t)(b * 4 + h) * 256 + d] = Cacc[i][2][r]; }
      if (j == 0 && tid == 0) a.out[O_MP + b * 4 + h] = GA[323]; }
#undef ML_LOADKV
#undef ML_LOADQ
}

__device__ __forceinline__ void mlnorm_rows4(const Args& a, int tok0, int tstride, int lane) {
    unsigned char* ws = a.ws;
    const float* MLH = (const float*)(ws + WS_MLH); const float* HSSP = (const float*)(ws + WS_HSSP); const bf16_t* Z = (const bf16_t*)(ws + WS_Z); bf16_t* MLO = (bf16_t*)(ws + WS_MLO);
    const int hh = lane >> 4, sl = lane & 15, c0 = 16 * lane;
    f32x4 gh[4];
#pragma unroll
    for (int q = 0; q < 4; ++q) gh[q] = *(const f32x4*)(a.in[I_GHEAD] + c0 + 4 * q);
    float hs[4]; f32x4 hv[4][4]; u32x4 oz[4][2]; bool ok[4];
#pragma unroll
    for (int k = 0; k < 4; ++k) { const int tok = tok0 + k * tstride; ok[k] = tok < NPR; const size_t t = ok[k] ? tok : 0;
        hs[k] = HSSP[((size_t)sl * 4 + hh) * NPR + t];
#pragma unroll
        for (int q = 0; q < 4; ++q) hv[k][q] = *(const f32x4*)(MLH + t * 1024 + c0 + 4 * q);
        oz[k][0] = *(const u32x4*)(Z + t * ZW + 4096 + c0); oz[k][1] = *(const u32x4*)(Z + t * ZW + 4096 + c0 + 8); }
#pragma unroll
    for (int k = 0; k < 4; ++k) {
        float h = hs[k]; h += __shfl_xor(h, 1); h += __shfl_xor(h, 2); h += __shfl_xor(h, 4); h += __shfl_xor(h, 8);
        const float rstd = rsqrtf(h * (1.0f / 256.0f) + EPS);
        const unsigned ow[8] = {oz[k][0].x, oz[k][0].y, oz[k][0].z, oz[k][0].w, oz[k][1].x, oz[k][1].y, oz[k][1].z, oz[k][1].w};
        unsigned pw[8];
#pragma unroll
        for (int q = 0; q < 4; ++q) { const f32x4 v = hv[k][q] * rstd * gh[q];
            pw[2 * q] = pk2(v[0] * sigm(bflo(ow[2 * q])), v[1] * sigm(bfhi(ow[2 * q]))); pw[2 * q + 1] = pk2(v[2] * sigm(bflo(ow[2 * q + 1])), v[3] * sigm(bfhi(ow[2 * q + 1]))); }
        if (ok[k]) { const size_t t = tok0 + k * tstride; u32x4 w0, w1; w0.x = pw[0]; w0.y = pw[1]; w0.z = pw[2]; w0.w = pw[3]; w1.x = pw[4]; w1.y = pw[5]; w1.z = pw[6]; w1.w = pw[7];
            *(u32x4*)(MLO + t * 1024 + c0) = w0; *(u32x4*)(MLO + t * 1024 + c0 + 8) = w1; } }
}

template <int MODE>
__device__ __forceinline__ void finalize_rows(const Args& a, int nslots, float* ssdst) {
    unsigned char* ws = a.ws; const float* PART = (const float*)(ws + WS_PART); float* X = (float*)(ws + WS_X); bf16_t* XB = (bf16_t*)(ws + WS_XB); bf16_t* MB = (bf16_t*)(ws + WS_MB);
    const int tid = pg8::opaque_tid(), lane = tid & 63, wave = tid >> 6;
    for (int r = blockIdx.x * 8 + wave; r < NSM; r += gridDim.x * 8) { const size_t row = (size_t)NPR + r; float sq = 0.f;
#pragma unroll
        for (int q = 0; q < 8; ++q) { const int cc = 4 * (lane + 64 * q); f32x4 acc = (f32x4){0.f, 0.f, 0.f, 0.f};
            for (int sl = 0; sl < nslots; ++sl) acc = acc + *(const f32x4*)(PART + ((size_t)sl * 128 + r) * DM + cc);
            if (MODE == 3) { u32x2 w; w.x = pk2(acc[0], acc[1]); w.y = pk2(acc[2], acc[3]); *(u32x2*)(MB + row * DM + cc) = w; }
            else { const f32x4 v = (MODE == 0) ? *(const f32x4*)(a.in[I_XS] + (size_t)r * DM + cc) + acc * 0.5f : *(const f32x4*)(X + row * DM + cc) + acc;
                *(f32x4*)(X + row * DM + cc) = v; u32x2 w; w.x = pk2(v[0], v[1]); w.y = pk2(v[2], v[3]); *(u32x2*)(XB + row * DM + cc) = w;
                sq += (v[0] * v[0] + v[1] * v[1]) + (v[2] * v[2] + v[3] * v[3]); } }
        if (MODE != 3) { sq = wave_sum(sq); if (lane == 0) ssdst[row] = sq; } }
}
#define XB_TMO      128
#define XB_XCNT(j)  (256  + 64 * (j))
#define XB_XSUB(j)  (1280 + 64 * (j))
#define XB_XGEN(j)  (2304 + 64 * (j))
#define XB_TOP      3328
#define XB_TOPGEN   3392
#define XCD_BAR_WORDS 3456
#define XB_SPIN_CAP (1u << 18)

__device__ __forceinline__ unsigned xb_ld(unsigned* p)              { return __hip_atomic_load(p, __ATOMIC_RELAXED, __HIP_MEMORY_SCOPE_AGENT); }
__device__ __forceinline__ unsigned xb_add(unsigned* p, unsigned v) { return __hip_atomic_fetch_add(p, v, __ATOMIC_RELAXED, __HIP_MEMORY_SCOPE_AGENT); }
__device__ __forceinline__ unsigned xb_xcc_id() { return (unsigned)__builtin_amdgcn_s_getreg((3 << 11) | 20) & 0xFu; }
#define XB_SPIN(cond, bar) do { unsigned _sp = 0; while (cond) { __builtin_amdgcn_s_sleep(1); \
    if ((++_sp & 255u) == 0u) { if (xb_ld(&(bar)[XB_TMO])) break; if (_sp > XB_SPIN_CAP) { atomicAdd(&(bar)[XB_TMO], 1u); break; } } } } while (0)

struct XcdBarrier {
    unsigned* bar; unsigned x;
    volatile LAS unsigned* st;
};

__device__ __forceinline__ XcdBarrier xcd_barrier_post(unsigned* bar, volatile LAS unsigned* st) {
    XcdBarrier b; b.bar = bar; b.x = xb_xcc_id(); b.st = st;
    if (threadIdx.x == 0) (void)xb_add(&bar[XB_XCNT(b.x)], 1u);
    return b;
}
__device__ __forceinline__ void xcd_barrier_complete(unsigned* bar, unsigned x, unsigned& nloc, unsigned& nx) {
    const unsigned G = gridDim.x * gridDim.y * gridDim.z;
    unsigned sum, cnt, mine, sp = 0u;
    for (;;) {
        sum = 0u; cnt = 0u; mine = 0u;
#pragma unroll
        for (unsigned j = 0; j < 16; ++j) { const unsigned c = xb_ld(&bar[XB_XCNT(j)]); sum += c; cnt += (c > 0u) ? 1u : 0u; mine = (j == x) ? c : mine; }
        if (sum == G) break;
        __builtin_amdgcn_s_sleep(1);
        if ((++sp & 255u) == 0u) { if (xb_ld(&bar[XB_TMO])) break; if (sp > XB_SPIN_CAP) { atomicAdd(&bar[XB_TMO], 1u); break; } }
    }
    nloc = mine > 0u ? mine : 1u; nx = cnt > 0u ? cnt : 1u;
}

__device__ __forceinline__ void xcd_barrier(const XcdBarrier& b) {
    asm volatile("s_waitcnt vmcnt(0)" ::: "memory");
    __syncthreads();
    if (threadIdx.x == 0) {
        unsigned* bar = b.bar;
        __builtin_amdgcn_s_waitcnt(0);
        unsigned nloc = b.st[0], nx = b.st[1];
        if (nloc == 0u) { xcd_barrier_complete(bar, b.x, nloc, nx); b.st[0] = nloc; b.st[1] = nx; }
        const unsigned old = xb_add(&bar[XB_XSUB(b.x)], 1u);
        const unsigned gen = old / nloc;
        if (old + 1u == (gen + 1u) * nloc) {
            __builtin_amdgcn_fence(__ATOMIC_RELEASE, "agent");
            asm volatile("s_waitcnt vmcnt(0)" ::: "memory");
            const unsigned og = xb_add(&bar[XB_TOP], 1u);
            const unsigned tg = og / nx;
            if (og + 1u == (tg + 1u) * nx) xb_add(&bar[XB_TOPGEN], 1u);
            else XB_SPIN(xb_ld(&bar[XB_TOPGEN]) == tg, bar);
            __builtin_amdgcn_fence(__ATOMIC_ACQUIRE, "agent");
            xb_add(&bar[XB_XGEN(b.x)], 1u);
            asm volatile("s_waitcnt vmcnt(0)" ::: "memory");
        } else {
            XB_SPIN(xb_ld(&bar[XB_XGEN(b.x)]) == gen, bar);
            __builtin_amdgcn_fence(__ATOMIC_ACQUIRE, "agent");
            asm volatile("s_waitcnt vmcnt(0)" ::: "memory");
        }
    }
    __syncthreads();
}
#define QLOOP0(ctr, limit, BODY) do { volatile LAS int* slot_ = (volatile LAS int*)(lds + LDS_MISC); \
        for (;;) { __syncthreads(); if (threadIdx.x == 0) *slot_ = (int)atomicAdd((ctr), 1u); __syncthreads(); const int it = *slot_; if (it >= (limit)) break; BODY; } } while (0)
#define QLOOP(ctr, limit, BODY) do { volatile LAS int* slot_ = (volatile LAS int*)(lds + LDS_MISC); int tk_ = 0; \
        if (threadIdx.x == 0) tk_ = (int)atomicAdd((ctr), 1u); \
        for (;;) { __syncthreads(); if (threadIdx.x == 0) *slot_ = tk_; __syncthreads(); const int it = *slot_; if (it >= (limit)) break; \
            if (threadIdx.x == 0) tk_ = (int)atomicAdd((ctr), 1u); \
            BODY; } } while (0)
__global__ void __launch_bounds__(512, 2) hybrid_fwd(Args a) {
    extern __shared__ __attribute__((aligned(16))) unsigned char lds_raw[];
    LAS unsigned char* lds = (LAS unsigned char*)lds_raw;
    cg::grid_group grid = cg::this_grid();
    unsigned char* ws = a.ws;
    const int G = gridDim.x, c = blockIdx.x;
    float* ctlf = (float*)(ws + WS_CTL); unsigned* ctlu = (unsigned*)(ws + WS_CTL);
    if (threadIdx.x < 2) ((volatile LAS unsigned*)(lds + LDS_MISC + 16))[threadIdx.x] = 0u;
    __syncthreads();
    bf16_t* XB = (bf16_t*)(ws + WS_XB); bf16_t* H = (bf16_t*)(ws + WS_H); float* X = (float*)(ws + WS_X); bf16_t* Z = (bf16_t*)(ws + WS_Z);
    constexpr size_t TS2048 = 256 * 2048 * 2, TS5504 = (size_t)256 * 5504 * 2, TS1024 = 256 * 1024 * 2;

#define GSYNC_CG() do { asm volatile("s_waitcnt vmcnt(0) lgkmcnt(0)" ::: "memory"); grid.sync(); \
    if (threadIdx.x == 0) { __builtin_amdgcn_fence(__ATOMIC_ACQUIRE, "agent"); asm volatile("s_waitcnt vmcnt(0)" ::: "memory"); } __syncthreads(); } while (0)
#define GSYNC() xcd_barrier(xbar)
#ifndef PHMASK
#define PHMASK 0xFFFF
#endif
#define PH(n) if constexpr (((PHMASK) >> (n)) & 1)
    const XcdBarrier xbar = xcd_barrier_post(ctlu + CW_BAR, (volatile LAS unsigned*)(lds + LDS_MISC + 16));
    PH(0) p0_prologue(a, lds);
    GSYNC();
    PH(1) { pg8::Order S{(const char*)XB, (const char*)(ws + WS_W1GU), (long)WS_MEMB - (long)WS_XB, (long)WS_WMEM - (long)WS_W1GU, 33, 43, 4 - 33, 8 - 43, 33 * 43, 33 * 43 + 32, 1, G, c, TS2048, 32, 0, 1, 1, 32};
      EpiGU E{H, ctlf + CW_SS1, ctlf + CW_SSM, a.out + O_MK, a.out + O_MV, (bf16_t*)(ws + WS_MKB), (bf16_t*)(ws + WS_MVT)};
      pg8::gemm_phase<EpiGU, pg8::Order, true, true>(lds, pg8::Gemm{DM}, S, E);
      { const int tidt = pg8::opaque_tid(), lane = tidt & 63, wave = tidt >> 6;
        QLOOP(ctlu + CW_Q + 6, TRC_DN / 8, tr_dispatch(a, 4 * TRC_GU + it * 8 + wave, lane)); } }
    GSYNC();
    PH(2) { pg8::Order S{(const char*)H, (const char*)(ws + WS_W1D), 0, 0, 32, 8, 0, 0, 256, 256, 1, G, c, TS5504, 86, 64, 8, 43, 32};
      EpiRes<0> E{a.in[I_XP], a.in[I_XS], X, XB, ctlf + CW_SS2, (float*)(ws + WS_PART)};
      pg8::gemm_phase<EpiRes<0>, pg8::Order, true, true>(lds, pg8::Gemm{FF}, S, E);
      { const int tidt = pg8::opaque_tid(), lane = tidt & 63, wave = tidt >> 6;
        QLOOP(ctlu + CW_Q + 9, TRC_IN / 8, tr_dispatch(a, 4 * TRC_GU + 2 * TRC_DN + it * 8 + wave, lane)); } }
    GSYNC();
    PH(2) finalize_rows<0>(a, 8, ctlf + CW_SS2);
    GSYNC();
    PH(3) { pg8::Order S{(const char*)XB, (const char*)(ws + WS_WIN), 0, 0, 33, 49, 0, 0, 33 * 49, 33 * 49, 1, G, c, TS2048, 32, 0, 1, 1, 32};
      EpiZ E{Z, (float*)(ws + WS_IF), ctlf + CW_SS2};
      pg8::gemm_phase<EpiZ, pg8::Order, true, true>(lds, pg8::Gemm{DM}, S, E);
      { const int tidt = pg8::opaque_tid(), lane = tidt & 63, wave = tidt >> 6;
        QLOOP(ctlu + CW_Q + 7, (2 * TRC_GU) / 8, tr_dispatch(a, 2 * TRC_GU + it * 8 + wave, lane)); } }
    GSYNC();
    PH(4) {
      if (c < 128) mlstm_prompt(a, lds, c);
      QLOOP0(ctlu + CW_Q + 1, 512, mlstm_sample(a, lds, it));
      QLOOP0(ctlu + CW_Q + 2, 512, xatt_sample(a, lds, it));
      QLOOP0(ctlu + CW_Q + 3, 256, xatt_prompt(a, lds, it));
      { const int tid4 = pg8::opaque_tid(), lane = tid4 & 63, wave = tid4 >> 6;
        QLOOP0(ctlu + CW_Q + 4, 512, s5_wave<0>(a, lds + wave * 13312, it * 8 + wave, lane));
        QLOOP(ctlu + CW_Q + 5, 1024, s5_wave<2>(a, lds + wave * 13312, it * 8 + wave, lane));
        QLOOP(ctlu + CW_Q + 8, (TRC_GL + 3 * TRC_BR + TRC_WO) / 8, { const int w_ = it * 8 + wave; const int base_ = 4 * TRC_GU + 2 * TRC_DN + TRC_IN;
            tr_dispatch(a, w_ < TRC_GL ? base_ + w_ : base_ + 2 * TRC_MK + w_, lane); }); } }
    GSYNC();
    PH(5) { const int tid5 = pg8::opaque_tid(), lane = tid5 & 63, wave = tid5 >> 6; for (int it = c; it < 512; it += G) s5_wave<1>(a, lds + wave * 13312, it * 8 + wave, lane);
            for (int tok = c * 8 + wave; tok < NPR; tok += G * 32) mlnorm_rows4(a, tok, G * 8, lane); }
    GSYNC();
    PH(6) { pg8::Order S{(const char*)(ws + WS_S5Y), (const char*)(ws + WS_WGLU), 0, 0, 33, 4, 0, 0, 132, 132, 1, G, c, TS1024, 16, 0, 1, 1, 32};
      EpiGLU E{(const bf16_t*)(ws + WS_S5Y), (bf16_t*)(ws + WS_S5O)};
      pg8::gemm_phase<EpiGLU, pg8::Order, true, true>(lds, pg8::Gemm{1024}, S, E); }
    GSYNC();
    PH(7) { pg8::Order S{(const char*)(ws + WS_S5O), (const char*)(ws + WS_WBR), (long)(17 * MiB), (long)DM * 1024 * 2, 32, 8, 0, 0, 256, 256, 3, G, c, TS1024, 16, 48, 2, 8, 32};
      EpiBR E{Z, (float*)(ws + WS_MERGED), (bf16_t*)(ws + WS_MB), (float*)(ws + WS_PART)};
      pg8::gemm_phase<EpiBR, pg8::Order, true, true>(lds, pg8::Gemm{1024}, S, E); }
    GSYNC();
    PH(7) finalize_rows<3>(a, 6, nullptr);
    GSYNC();
    PH(8) { pg8::Order S{(const char*)(ws + WS_MB), (const char*)(ws + WS_WOUT), 0, 0, 32, 8, 0, 0, 256, 256, 1, G, c, TS2048, 32, 64, 8, 16, 32};
      EpiRes<1> E{nullptr, nullptr, X, XB, ctlf + CW_SS3, (float*)(ws + WS_PART)};
      pg8::gemm_phase<EpiRes<1>, pg8::Order, true, true>(lds, pg8::Gemm{DM}, S, E); }
    GSYNC();
    PH(8) finalize_rows<1>(a, 8, ctlf + CW_SS3);
    GSYNC();
    PH(9) { pg8::Order S{(const char*)XB, (const char*)(ws + WS_W2GU), 0, 0, 33, 43, 0, 0, 33 * 43, 33 * 43, 1, G, c, TS2048, 32, 0, 1, 1, 32};
      EpiGU E{H, ctlf + CW_SS3, nullptr, nullptr, nullptr, nullptr, nullptr};
      pg8::gemm_phase<EpiGU, pg8::Order, true, true>(lds, pg8::Gemm{DM}, S, E);
      { const int tidt = pg8::opaque_tid(), lane = tidt & 63, wave = tidt >> 6;
        QLOOP(ctlu + CW_Q + 10, TRC_DN / 8, tr_dispatch(a, 4 * TRC_GU + TRC_DN + it * 8 + wave, lane)); } }
    GSYNC();
    PH(10) { pg8::Order S{(const char*)H, (const char*)(ws + WS_W2D), 0, 0, 32, 8, 0, 0, 256, 256, 1, G, c, TS5504, 86, 64, 8, 43, 32};
      EpiRes<2> E{nullptr, nullptr, X, nullptr, nullptr, (float*)(ws + WS_PART)};
      pg8::gemm_phase<EpiRes<2>, pg8::Order, true, true>(lds, pg8::Gemm{FF}, S, E); }
    GSYNC();
    PH(11) { const int tid11 = pg8::opaque_tid(), lane = tid11 & 63, wave = tid11 >> 6; const float* PART = (const float*)(ws + WS_PART);
      for (int row = c * 8 + wave; row < NT; row += G * 8) { f32x4 v[8]; float sq = 0.f;
#pragma unroll
        for (int q = 0; q < 8; ++q) { const int cc = 4 * (lane + 64 * q); v[q] = *(const f32x4*)(X + (size_t)row * DM + cc);
            if (row >= NPR) { f32x4 acc = (f32x4){0.f, 0.f, 0.f, 0.f};
#pragma unroll
                for (int sl = 0; sl < 8; ++sl) acc = acc + *(const f32x4*)(PART + ((size_t)sl * 128 + (row - NPR)) * DM + cc);
                v[q] = v[q] + acc * 0.5f; }
            sq += (v[q][0] * v[q][0] + v[q][1] * v[q][1]) + (v[q][2] * v[q][2] + v[q][3] * v[q][3]); }
        const float rstd = rsqrtf(wave_sum(sq) * (1.0f / DM) + EPS);
#pragma unroll
        for (int q = 0; q < 8; ++q) { const int cc = 4 * (lane + 64 * q); const f32x4 gf = *(const f32x4*)(a.in[I_GFIN] + cc); *(f32x4*)(a.out + O_Y + (size_t)row * DM + cc) = v[q] * rstd * gf; } } }
}

extern "C" void kernel_launch(void* const* d_in, const int* in_sizes, int n_in, void* d_out, int out_size, void* d_ws, size_t ws_size, hipStream_t stream) {
    static int grid = 0;
    if (grid == 0) {
        if (n_in != 40 || out_size != (int)O_END || ws_size < WS_END) { fprintf(stderr, "kernel_launch: unexpected problem (n_in %d, out %d, ws %zu)\n", n_in, out_size, ws_size); grid = -1; return; }
        int dev = 0, cus = 0, per_cu = 0;
        hipGetDevice(&dev); hipDeviceGetAttribute(&cus, hipDeviceAttributeMultiprocessorCount, dev);
        hipFuncSetAttribute((const void*)hybrid_fwd, hipFuncAttributeMaxDynamicSharedMemorySize, LDS_BYTES);
        hipOccupancyMaxActiveBlocksPerMultiprocessor(&per_cu, (const void*)hybrid_fwd, 512, LDS_BYTES);
        (void)hipGetLastError();
        if (per_cu < 1) per_cu = 1;
        grid = cus * per_cu;
        if (grid != 256) { fprintf(stderr, "kernel_launch: this build needs a 256-workgroup grid (got %d)\n", grid); grid = -1; return; }
        fprintf(stderr, "kernel_launch: %d CUs x %d = grid %d\n", cus, per_cu, grid);
    }
    if (grid < 0) return;
    if (hipMemsetAsync((char*)d_ws + WS_CTL + (size_t)CW_BAR * 4, 0, 3456 * 4, stream) != hipSuccess) { fprintf(stderr, "kernel_launch: memset of the barrier words failed\n"); return; }
    Args a{};
    for (int i = 0; i < 40; ++i) a.in[i] = (const float*)d_in[i];
    a.out = (float*)d_out; a.ws = (unsigned char*)d_ws;
    void* args[] = {&a};
    hipError_t e = hipLaunchCooperativeKernel((const void*)hybrid_fwd, dim3(grid), dim3(512), args, LDS_BYTES, stream);
    if (e != hipSuccess) fprintf(stderr, "cooperative launch failed: %s (grid %d)\n", hipGetErrorString(e), grid);
}
```

```cpp
#include <hip/hip_runtime.h>
#include <hip/hip_cooperative_groups.h>
#include <cstdio>
#include <cstdint>
namespace cg = cooperative_groups;
namespace pg8 {
#define PG8_LAS __attribute__((address_space(3)))
typedef unsigned short bf16_t;
typedef short bf16x8 __attribute__((ext_vector_type(8)));
typedef float f32x4 __attribute__((ext_vector_type(4)));
typedef unsigned u32x4 __attribute__((ext_vector_type(4)));
constexpr int BM = 256, BK = 64, HALF = 128, HTB = HALF * BK * 2  , STAGE_BYTES = 8 * HTB, NXCD = 8, WGM = 8;

__host__ __device__ __forceinline__ int lds_byte(int r, int c) { const int st = (r >> 4) * 2 + (c >> 5), rr = r & 15, cc = c & 31, ob = rr * 64 + cc * 2; return st * 1024 + (ob ^ (((ob >> 9) & 1) << 5)); }
__host__ __device__ __forceinline__ void stage_rc(int b, int& R, int& C) { const int st = b / 1024, sb = b % 1024, swz = sb ^ (((sb >> 9) & 1) << 5); R = (st >> 1) * 16 + swz / 64; C = (st & 1) * 32 + (swz % 64) / 2; }
__host__ __device__ __forceinline__ int perm32(int rho) { const int n = rho >> 4, i = rho & 15; return 8 * (i >> 2) + 4 * n + (i & 3); }

struct Unit { int pm, pn, kind, k0, nt, split, slot; };
struct Gemm { int K; };
struct Order {
    const char* A0; const char* B0; long dA, dB;
    int nM0, nN0, dM, dN, n0, ntot, rep, G, c; size_t tstep;
    int ntFull, nsp, spS, spPairs, spPm;
    __device__ __forceinline__ bool next(int i, Unit& u) const {
        int r = 0, ii = i; if (rep > 1) { r = i % rep; ii = i / rep; }
        const long L = (long)ii * G + c;
        if (L < ntot) {
            int id = (int)L; const int s = (id >= n0) ? 1 : 0; id -= s * n0;
            const int nM = nM0 + s * dM, nN = nN0 + s * dN, nwg = nM * nN;
            int wgid = id; { const int q = nwg / NXCD, rr = nwg % NXCD, xcd = wgid % NXCD, off = wgid / NXCD; wgid = (xcd < rr ? xcd * (q + 1) : rr * (q + 1) + (xcd - rr) * q) + off; }
            const int nig = WGM * nN, gid = wgid / nig, fm = gid * WGM, gsz = (nM - fm) < WGM ? (nM - fm) : WGM;
            u.pm = fm + ((wgid % nig) % gsz); u.pn = (wgid % nig) / gsz; u.kind = rep > 1 ? r : s; u.k0 = 0; u.nt = ntFull; u.split = 0; u.slot = 0; return true;
        }
        if (nsp == 0) return false;
        const int rounds_main = (ntot / G) * rep; if (i < rounds_main) return false;
        const long e = (long)(i - rounds_main) * G + c; if (e >= nsp) return false;
        const int ee = (int)e, q = ee >> 3, ks = q % spS, p0 = (ks * spPairs) / spS, p1 = ((ks + 1) * spPairs) / spS;
        u.pm = spPm; u.pn = ee & 7; u.kind = q / spS; u.k0 = 128 * p0; u.nt = 2 * (p1 - p0); u.split = 1; u.slot = q; return true;
    }
    __device__ __forceinline__ const char* aptr(const Unit& u) const { return A0 + (long)u.kind * dA + (size_t)u.pm * tstep + (size_t)u.k0 * 2; }
    __device__ __forceinline__ const char* bptr(const Unit& u) const { return B0 + (long)u.kind * dB + (size_t)u.pn * tstep + (size_t)u.k0 * 2; }
    __device__ __forceinline__ void a_ready(const Unit&) const {}
    __device__ __forceinline__ void done(const Unit&) const {}
};
typedef float cvt_f32x2_t __attribute__((ext_vector_type(2)));
typedef __bf16 cvt_bf16x2_t __attribute__((ext_vector_type(2)));
__device__ __forceinline__ unsigned cvt_pk_bf16(float lo, float hi) { cvt_f32x2_t v = {lo, hi}; cvt_bf16x2_t b = __builtin_convertvector(v, cvt_bf16x2_t); return __builtin_bit_cast(unsigned, b); }
__device__ __forceinline__ int opaque_tid() { int t = threadIdx.x; asm volatile("" : "+v"(t)); return t; }
template <class Epi, class Sched, bool ALIGN_EPI = false, bool SP2 = false>
__device__ __forceinline__ void gemm_phase(PG8_LAS unsigned char* lds, const Gemm g, const Sched& S, const Epi& E) {
    const int tid = opaque_tid(), wid = __builtin_amdgcn_readfirstlane(tid >> 6), lane = tid & 63, wr = wid >> 2, wc = wid & 3, fr = lane & 15, fq = lane >> 4;
    const int K = g.K; int nt = 0;
    unsigned voffA[2], voffB[2];
#pragma unroll
    for (int i = 0; i < 2; ++i) { int R, C; stage_rc(tid * 16 + i * 8192, R, C); const int Rb = Epi::PERM ? ((R & ~31) + perm32(R & 31)) : R;
        voffA[i] = (unsigned)(R * K + C) * 2u; voffB[i] = (unsigned)(Rb * K + C) * 2u; }
    const size_t kstep = (size_t)(BK * 2);
    const size_t hstep = (size_t)HALF * K * 2;
        const unsigned ldsw = (unsigned)wid * 1024u;
    const int aoff = lds_byte(wr * 64 + fr, fq * 8), boff = lds_byte(wc * 32 + fr, fq * 8);
#define PG8_SA(b, h) (((b) * 2 + (h)) * HTB)
#define PG8_SB(b, h) ((4 + (b) * 2 + (h)) * HTB)
#define PG8_STAGE(bufoff, gbase, voff) do { _Pragma("unroll") for (int _i = 0; _i < 2; ++_i) \
        __builtin_amdgcn_global_load_lds((const unsigned*)((const char*)(gbase) + (voff)[_i]), (PG8_LAS unsigned*)(lds + (bufoff) + ldsw + _i * 8192), 16, 0, 0); } while (0)
#define PG8_LDA(dst, b, h) do { _Pragma("unroll") for (int m = 0; m < 4; ++m) _Pragma("unroll") for (int k = 0; k < 2; ++k) dst[m][k] = *(const PG8_LAS bf16x8*)(lds + PG8_SA(b, h) + aoff + m * 2048 + k * 1024); } while (0)
#define PG8_LDB(dst, b, h) do { _Pragma("unroll") for (int n = 0; n < 2; ++n) _Pragma("unroll") for (int k = 0; k < 2; ++k) dst[n][k] = *(const PG8_LAS bf16x8*)(lds + PG8_SB(b, h) + boff + n * 2048 + k * 1024); } while (0)
#define PG8_MMA(ai, bj, At, Bt) do { __builtin_amdgcn_s_setprio(1); _Pragma("unroll") for (int m = 0; m < 4; ++m) _Pragma("unroll") for (int n = 0; n < 2; ++n) _Pragma("unroll") for (int k = 0; k < 2; ++k) \
        acc[ai][bj][m][n] = __builtin_amdgcn_mfma_f32_16x16x32_bf16(Bt[n][k], At[m][k], acc[ai][bj][m][n], 0, 0, 0); __builtin_amdgcn_s_setprio(0); } while (0)
#define PG8_WAIT_V(n) asm volatile("s_waitcnt vmcnt(" #n ")" ::: "memory")
#define PG8_WAIT_L(n) asm volatile("s_waitcnt lgkmcnt(" #n ")" ::: "memory")
#define PG8_BAR __builtin_amdgcn_s_barrier()
#define PG8_SCHED __builtin_amdgcn_sched_barrier(0)
    Unit cur, nxt; int ui = 0;
    if (!S.next(0, cur)) return;
    nt = cur.nt;
    f32x4 acc[2][2][4][2];
#pragma unroll
    for (int a = 0; a < 2; ++a)
#pragma unroll
        for (int b = 0; b < 2; ++b)
#pragma unroll
            for (int m = 0; m < 4; ++m)
#pragma unroll
                for (int n = 0; n < 2; ++n) acc[a][b][m][n] = (f32x4){0.f, 0.f, 0.f, 0.f};
    bf16x8 At[4][2], B0[2][2], B1[2][2];
    const char* cA = S.aptr(cur); const char* cB = S.bptr(cur);
    S.a_ready(cur);
    if constexpr (SP2) {
        PG8_STAGE(PG8_SB(0, 0), cB, voffB); PG8_STAGE(PG8_SB(0, 1), cB + hstep, voffB); PG8_STAGE(PG8_SA(0, 0), cA, voffA); PG8_STAGE(PG8_SA(0, 1), cA + hstep, voffA);
        if (wr == 1) PG8_BAR;
        PG8_WAIT_V(2); PG8_BAR;
        PG8_STAGE(PG8_SB(1, 0), cB + kstep, voffB); PG8_STAGE(PG8_SA(1, 0), cA + kstep, voffA); PG8_STAGE(PG8_SB(1, 1), cB + hstep + kstep, voffB);
        PG8_WAIT_V(6); PG8_BAR;
    } else {
        PG8_STAGE(PG8_SB(0, 0), cB, voffB); PG8_STAGE(PG8_SA(0, 0), cA, voffA); PG8_STAGE(PG8_SB(0, 1), cB + hstep, voffB); PG8_STAGE(PG8_SA(0, 1), cA + hstep, voffA);
        if (wr == 1) PG8_BAR;
        PG8_WAIT_V(4); PG8_BAR;
        PG8_STAGE(PG8_SB(1, 0), cB + kstep, voffB); PG8_STAGE(PG8_SA(1, 0), cA + kstep, voffA); PG8_STAGE(PG8_SB(1, 1), cB + hstep + kstep, voffB);
        PG8_WAIT_V(6); PG8_BAR;
    }
    for (;;) {
        const bool has_next = S.next(ui + 1, nxt);
        const char* nA = has_next ? S.aptr(nxt) : cA; const char* nB = has_next ? S.bptr(nxt) : cB;
        for (int t = 0; t < nt; t += 2) {
            const bool last = (t == nt - 2);
            const char* a1 = cA + (size_t)(t + 1) * kstep;
            const char* a2 = last ? nA : cA + (size_t)(t + 2) * kstep; const char* b2 = last ? nB : cB + (size_t)(t + 2) * kstep;
            const char* a3 = a2 + kstep; const char* b3 = b2 + kstep;
            if (last && has_next) S.a_ready(nxt);
            if constexpr (SP2) {
            PG8_LDB(B0, 0, 0); PG8_LDB(B1, 0, 1); PG8_SCHED; PG8_LDA(At, 0, 0); PG8_STAGE(PG8_SA(1, 1), a1 + hstep, voffA);
            PG8_WAIT_V(8); PG8_WAIT_L(0); PG8_BAR; PG8_MMA(0, 0, At, B0); PG8_MMA(0, 1, At, B1); PG8_BAR; PG8_SCHED;
            PG8_LDA(At, 0, 1); PG8_STAGE(PG8_SB(0, 0), b2, voffB); PG8_STAGE(PG8_SB(0, 1), b2 + hstep, voffB); PG8_STAGE(PG8_SA(0, 0), a2, voffA);
            PG8_WAIT_V(8); PG8_WAIT_L(0); PG8_BAR; PG8_MMA(1, 0, At, B0); PG8_MMA(1, 1, At, B1); PG8_BAR; PG8_SCHED;
            PG8_LDB(B0, 1, 0); PG8_LDB(B1, 1, 1); PG8_SCHED; PG8_LDA(At, 1, 0); PG8_STAGE(PG8_SA(0, 1), a2 + hstep, voffA);
            PG8_WAIT_V(8); PG8_WAIT_L(0); PG8_BAR; PG8_MMA(0, 0, At, B0); PG8_MMA(0, 1, At, B1); PG8_BAR; PG8_SCHED;
            PG8_LDA(At, 1, 1); PG8_STAGE(PG8_SB(1, 0), b3, voffB); PG8_STAGE(PG8_SB(1, 1), b3 + hstep, voffB); PG8_STAGE(PG8_SA(1, 0), a3, voffA);
            PG8_WAIT_V(8); PG8_WAIT_L(0); PG8_BAR; PG8_MMA(1, 0, At, B0); PG8_MMA(1, 1, At, B1); PG8_BAR; PG8_SCHED;
            } else {
            PG8_LDB(B0, 0, 0); PG8_SCHED; PG8_LDA(At, 0, 0); PG8_STAGE(PG8_SA(1, 1), a1 + hstep, voffA);
            PG8_WAIT_L(8); PG8_BAR; PG8_WAIT_L(0); PG8_MMA(0, 0, At, B0); PG8_BAR; PG8_SCHED;
            PG8_LDB(B1, 0, 1); PG8_STAGE(PG8_SB(0, 0), b2, voffB);
            PG8_BAR; PG8_WAIT_L(0); PG8_MMA(0, 1, At, B1); PG8_BAR;
            PG8_LDA(At, 0, 1); PG8_STAGE(PG8_SA(0, 0), a2, voffA);
            PG8_BAR; PG8_WAIT_L(0); PG8_MMA(1, 0, At, B0); PG8_BAR; PG8_SCHED;
            PG8_STAGE(PG8_SB(0, 1), b2 + hstep, voffB);
            PG8_WAIT_V(6); PG8_BAR; PG8_MMA(1, 1, At, B1); PG8_BAR;
            PG8_LDB(B0, 1, 0); PG8_SCHED; PG8_LDA(At, 1, 0); PG8_STAGE(PG8_SA(0, 1), a2 + hstep, voffA);
            PG8_WAIT_L(8); PG8_BAR; PG8_WAIT_L(0); PG8_MMA(0, 0, At, B0); PG8_BAR; PG8_SCHED;
            PG8_LDB(B1, 1, 1); PG8_STAGE(PG8_SB(1, 0), b3, voffB);
            PG8_BAR; PG8_WAIT_L(0); PG8_MMA(0, 1, At, B1); PG8_BAR;
            PG8_LDA(At, 1, 1); PG8_STAGE(PG8_SA(1, 0), a3, voffA);
            PG8_BAR; PG8_WAIT_L(0); PG8_MMA(1, 0, At, B0); PG8_BAR; PG8_SCHED;
            PG8_STAGE(PG8_SB(1, 1), b3 + hstep, voffB);
            PG8_WAIT_V(6); PG8_BAR; PG8_MMA(1, 1, At, B1); PG8_BAR;
            }
        }
        if constexpr (ALIGN_EPI) { if (wr == 0) PG8_BAR; }
        if constexpr (!Epi::AFTER_DRAIN) { E(acc, cur, wr, wc, fr, fq); S.done(cur); }
        if (!has_next) break;
#pragma unroll
        for (int a = 0; a < 2; ++a)
#pragma unroll
            for (int b = 0; b < 2; ++b)
#pragma unroll
                for (int m = 0; m < 4; ++m)
#pragma unroll
                    for (int n = 0; n < 2; ++n) acc[a][b][m][n] = (f32x4){0.f, 0.f, 0.f, 0.f};
        cur = nxt; cA = nA; cB = nB; ++ui; nt = cur.nt;
        if constexpr (ALIGN_EPI) { if (wr == 1) PG8_BAR; }
    }
    PG8_WAIT_V(0);
    if constexpr (!ALIGN_EPI) { if (wr == 0) PG8_BAR; }
    PG8_BAR;
    if constexpr (Epi::AFTER_DRAIN) { E.fused(acc, cur, wr, wc, fr, fq, lds, wid, lane); S.done(cur); }
#undef PG8_SA
#undef PG8_SB
#undef PG8_STAGE
#undef PG8_LDA
#undef PG8_LDB
#undef PG8_MMA
#undef PG8_WAIT_V
#undef PG8_WAIT_L
#undef PG8_BAR
#undef PG8_SCHED
}
}
#define LAS __attribute__((address_space(3)))
typedef unsigned short bf16_t;
typedef short bf16x8 __attribute__((ext_vector_type(8)));
typedef float f32x4 __attribute__((ext_vector_type(4)));
typedef float f32x2 __attribute__((ext_vector_type(2)));
typedef unsigned u32x4 __attribute__((ext_vector_type(4)));
typedef unsigned u32x2 __attribute__((ext_vector_type(2)));
constexpr int DM = 2048, NPR = 8192, NSM = 128, NT = 8320, MR = 8448, FF = 5504, NGU = 11008, ZW = 12288, NIN = 12544, SEQ = 2048;
constexpr float EPS = 1e-6f;
constexpr size_t MiB = 1u << 20;
constexpr size_t WS_CTL = 0, WS_W1GU = 1 * MiB, WS_W1D = 44 * MiB, WS_WIN = 66 * MiB, WS_WGLU = 115 * MiB, WS_WMEM = 117 * MiB, WS_WBR = 125 * MiB, WS_WOUT = 137 * MiB,
                 WS_W2GU = 145 * MiB, WS_W2D = 188 * MiB, WS_XB = 210 * MiB, WS_MEMB = 243 * MiB, WS_H = 247 * MiB, WS_X = 336 * MiB, WS_Z = 402 * MiB, WS_IF = 600 * MiB,
                 WS_S5Y = 601 * MiB, WS_S5O = 618 * MiB, WS_MLO = 635 * MiB, WS_XAO = 652 * MiB, WS_MLH = 669 * MiB, WS_MB = 702 * MiB, WS_MKB = 735 * MiB, WS_MVT = 737 * MiB,
                 WS_S5E = 739 * MiB, WS_S5T = 741 * MiB, WS_HSSP = 742 * MiB, WS_PART = 744 * MiB, WS_END = 752 * MiB;
constexpr size_t WS_MERGED = WS_H;
constexpr int CW_Q = 0, CW_SS1 = 1024, CW_SS2 = 9472, CW_SS3 = 17920, CW_SS4 = 26368, CW_SSM = 34816, CW_HSS = 35840, CW_END = 69632, CW_BAR = 70016;
constexpr size_t O_Y = 0, O_MK = 17039360, O_MV = 18087936, O_S5RP = 19136512, O_S5IP = 19152896, O_CP = 19169280, O_NP = 20217856, O_MP = 20221952,
                 O_S5RS = 20221968, O_S5IS = 20746256, O_CS = 21270544, O_NS = 54824976, O_MS = 54956048, O_END = 54956560;
constexpr int LDS_BYTES = 143360, LDS_MISC = 135168;
struct Args { const float* in[40]; float* out; unsigned char* ws; };
enum { I_XP = 0, I_XS, I_MEM, I_CK, I_CV, I_S5R, I_S5I, I_MC, I_MN, I_MM, I_GF1, I_W1G, I_W1U, I_W1D, I_GMIX, I_WIN, I_LRE, I_LIM, I_LSTEP, I_BRE, I_BIM, I_CRE, I_CIM, I_S5D, I_WGLU,
       I_BI, I_BF, I_GHEAD, I_GMEM, I_WMK, I_WMV, I_WBS5, I_WBML, I_WBXA, I_WOUT, I_GF2, I_W2G, I_W2U, I_W2D, I_GFIN };

__device__ __forceinline__ float bf2f(unsigned short b) { return __uint_as_float((unsigned)b << 16); }
__device__ __forceinline__ float bflo(unsigned u) { return __uint_as_float(u << 16); }
__device__ __forceinline__ float bfhi(unsigned u) { return __uint_as_float(u & 0xffff0000u); }
__device__ __forceinline__ unsigned pk2(float lo, float hi) { return pg8::cvt_pk_bf16(lo, hi); }
__device__ __forceinline__ unsigned short f2bf(float f) { return (unsigned short)(pg8::cvt_pk_bf16(f, 0.f) & 0xffffu); }
__device__ __forceinline__ float sigm(float x) { return __builtin_amdgcn_rcpf(1.0f + __expf(-x)); }
__device__ __forceinline__ float gelu_t(float x) { const float y = 0.7978845608028654f * (x + 0.044715f * x * x * x); const float t = 1.0f - 2.0f * __builtin_amdgcn_rcpf(__expf(2.0f * y) + 1.0f); return 0.5f * x * (1.0f + t); }
__device__ __forceinline__ float wave_sum(float v) {
#pragma unroll
    for (int o = 1; o < 64; o <<= 1) v += __shfl_xor(v, o);
    return v;
}
__device__ __forceinline__ float wave_max(float v) {
#pragma unroll
    for (int o = 1; o < 64; o <<= 1) v = fmaxf(v, __shfl_xor(v, o));
    return v;
}
#define LDS_WAIT() asm volatile("s_waitcnt lgkmcnt(0)" ::: "memory")
#define MFMA16(a, b, c) __builtin_amdgcn_mfma_f32_16x16x32_bf16((a), (b), (c), 0, 0, 0)

struct EpiGU {
    static constexpr bool PERM = true, AFTER_DRAIN = false;
    bf16_t* H; const float* ss; const float* ssm; float* outk; float* outv; bf16_t* MKB; bf16_t* MVT;
    __device__ __forceinline__ void operator()(const f32x4 (&acc)[2][2][4][2], const pg8::Unit& u, int wr, int wc, int fr, int fq) const {
        const int row0 = u.pm * 256 + wr * 64 + fr;
        if (u.kind == 0) {
            const int col0 = u.pn * 128 + wc * 32 + 8 * fq;
#pragma unroll
            for (int ai = 0; ai < 2; ++ai)
#pragma unroll
                for (int m = 0; m < 4; ++m) {
                    const int row = row0 + ai * 128 + m * 16; const float r = rsqrtf(ss[row] * (1.0f / DM) + EPS);
                    float hv[8];
#pragma unroll
                    for (int n = 0; n < 2; ++n)
#pragma unroll
                        for (int i = 0; i < 4; ++i) { const float g = acc[ai][0][m][n][i] * r, up = acc[ai][1][m][n][i] * r; hv[4 * n + i] = g * sigm(g) * up; }
                    u32x4 w; w.x = pk2(hv[0], hv[1]); w.y = pk2(hv[2], hv[3]); w.z = pk2(hv[4], hv[5]); w.w = pk2(hv[6], hv[7]);
                    *(u32x4*)(H + (size_t)row * FF + col0) = w;
                }
        } else {
#pragma unroll
            for (int ai = 0; ai < 2; ++ai)
#pragma unroll
                for (int m = 0; m < 4; ++m) {
                    const int row = row0 + ai * 128 + m * 16; const float r = rsqrtf(ssm[row] * (1.0f / DM) + EPS);
#pragma unroll
                    for (int bj = 0; bj < 2; ++bj) {
                        const int c = u.pn * 256 + bj * 128 + wc * 32 + 8 * fq;
                        const f32x4 v0 = acc[ai][bj][m][0] * r, v1 = acc[ai][bj][m][1] * r;
                        if (c < 1024) {
                            *(f32x4*)(outk + (size_t)row * 1024 + c) = v0; *(f32x4*)(outk + (size_t)row * 1024 + c + 4) = v1;
                            u32x4 w; w.x = pk2(v0[0], v0[1]); w.y = pk2(v0[2], v0[3]); w.z = pk2(v1[0], v1[1]); w.w = pk2(v1[2], v1[3]);
                            *(u32x4*)(MKB + (size_t)row * 1024 + c) = w;
                        } else {
                            const int cv = c - 1024;
                            *(f32x4*)(outv + (size_t)row * 1024 + cv) = v0; *(f32x4*)(outv + (size_t)row * 1024 + cv + 4) = v1;
                            const int b = row >> 8, key = row & 255, hh = cv >> 8, d = cv & 255;
                            bf16_t* vt = MVT + ((size_t)(b * 4 + hh) * 256 + d) * 256 + key;
#pragma unroll
                            for (int i = 0; i < 4; ++i) { vt[(size_t)i * 256] = f2bf(v0[i]); vt[(size_t)(i + 4) * 256] = f2bf(v1[i]); }
                        }
                    }
                }
        }
    }
};
template <int MODE>
struct EpiRes {
    static constexpr bool PERM = false, AFTER_DRAIN = false;
    const float* xp; const float* xs; float* X; bf16_t* XB; float* ss; float* PART;
    __device__ __forceinline__ void operator()(const f32x4 (&acc)[2][2][4][2], const pg8::Unit& u, int wr, int wc, int fr, int fq) const {
        const int row0 = u.pm * 256 + wr * 64 + fr, col0 = u.pn * 256 + wc * 32 + 4 * fq; const float sc = (MODE == 1) ? 1.0f : 0.5f;
        if (u.split) {
#pragma unroll
            for (int m = 0; m < 4; ++m)
#pragma unroll
                for (int bj = 0; bj < 2; ++bj)
#pragma unroll
                    for (int n = 0; n < 2; ++n) *(f32x4*)(PART + ((size_t)u.slot * 128 + wr * 64 + m * 16 + fr) * DM + col0 + bj * 128 + n * 16) = acc[0][bj][m][n];
            return;
        }
#pragma unroll
        for (int ai = 0; ai < 2; ++ai) {
            f32x4 bs[4][2][2];
#pragma unroll
            for (int m = 0; m < 4; ++m) { const int row = row0 + ai * 128 + m * 16; const float* bp = (MODE == 0) ? xp + (size_t)row * DM : X + (size_t)row * DM;
#pragma unroll
                for (int bj = 0; bj < 2; ++bj)
#pragma unroll
                    for (int n = 0; n < 2; ++n) bs[m][bj][n] = *(const f32x4*)(bp + col0 + bj * 128 + n * 16); }
#pragma unroll
            for (int m = 0; m < 4; ++m) { const int row = row0 + ai * 128 + m * 16; float sq = 0.f;
#pragma unroll
                for (int bj = 0; bj < 2; ++bj)
#pragma unroll
                    for (int n = 0; n < 2; ++n) {
                        const int c = col0 + bj * 128 + n * 16; const f32x4 v = bs[m][bj][n] + acc[ai][bj][m][n] * sc;
                        *(f32x4*)(X + (size_t)row * DM + c) = v;
                        if (MODE != 2) { u32x2 w; w.x = pk2(v[0], v[1]); w.y = pk2(v[2], v[3]); *(u32x2*)(XB + (size_t)row * DM + c) = w; }
                        sq += (v[0] * v[0] + v[1] * v[1]) + (v[2] * v[2] + v[3] * v[3]);
                    }
                sq += __shfl_xor(sq, 16); sq += __shfl_xor(sq, 32);
                if (MODE != 2 && fq == 0) atomicAdd(ss + row, sq); }
        }
    }
};
struct EpiZ {
    static constexpr bool PERM = true, AFTER_DRAIN = false;
    bf16_t* Z; float* IF; const float* ss;
    __device__ __forceinline__ void operator()(const f32x4 (&acc)[2][2][4][2], const pg8::Unit& u, int wr, int wc, int fr, int fq) const {
        const int row0 = u.pm * 256 + wr * 64 + fr;
#pragma unroll
        for (int ai = 0; ai < 2; ++ai)
#pragma unroll
            for (int m = 0; m < 4; ++m) {
                const int row = row0 + ai * 128 + m * 16; const float r = rsqrtf(ss[row] * (1.0f / DM) + EPS);
                if (u.pn < 48) {
#pragma unroll
                    for (int bj = 0; bj < 2; ++bj) {
                        const int c = u.pn * 256 + bj * 128 + wc * 32 + 8 * fq; const f32x4 v0 = acc[ai][bj][m][0] * r, v1 = acc[ai][bj][m][1] * r;
                        u32x4 w; w.x = pk2(v0[0], v0[1]); w.y = pk2(v0[2], v0[3]); w.z = pk2(v1[0], v1[1]); w.w = pk2(v1[2], v1[3]);
                        *(u32x4*)(Z + (size_t)row * ZW + c) = w;
                    }
                } else if (wc == 0 && fq == 0) {
                    *(f32x4*)(IF + (size_t)row * 8) = acc[ai][0][m][0] * r; *(f32x4*)(IF + (size_t)row * 8 + 4) = acc[ai][0][m][1] * r;
                }
            }
    }
};
struct EpiGLU {
    static constexpr bool PERM = true, AFTER_DRAIN = false;
    const bf16_t* Y; bf16_t* O;
    __device__ __forceinline__ void operator()(const f32x4 (&acc)[2][2][4][2], const pg8::Unit& u, int wr, int wc, int fr, int fq) const {
        const int row0 = u.pm * 256 + wr * 64 + fr;
#pragma unroll
        for (int ai = 0; ai < 2; ++ai)
#pragma unroll
            for (int m = 0; m < 4; ++m) {
                const int row = row0 + ai * 128 + m * 16;
#pragma unroll
                for (int bj = 0; bj < 2; ++bj) {
                    const int c = u.pn * 256 + bj * 128 + wc * 32 + 8 * fq; const u32x4 y = *(const u32x4*)(Y + (size_t)row * 1024 + c);
                    const f32x4 a0 = acc[ai][bj][m][0], a1 = acc[ai][bj][m][1];
                    u32x4 w; w.x = pk2(bflo(y.x) * sigm(a0[0]), bfhi(y.x) * sigm(a0[1])); w.y = pk2(bflo(y.y) * sigm(a0[2]), bfhi(y.y) * sigm(a0[3]));
                    w.z = pk2(bflo(y.z) * sigm(a1[0]), bfhi(y.z) * sigm(a1[1])); w.w = pk2(bflo(y.w) * sigm(a1[2]), bfhi(y.w) * sigm(a1[3]));
                    *(u32x4*)(O + (size_t)row * 1024 + c) = w;
                }
            }
    }
};
struct EpiBR {
    static constexpr bool PERM = false, AFTER_DRAIN = false;
    const bf16_t* Z; float* MG; bf16_t* MB; float* PART;
    __device__ __forceinline__ void operator()(const f32x4 (&acc)[2][2][4][2], const pg8::Unit& u, int wr, int wc, int fr, int fq) const {
        const int row0 = u.pm * 256 + wr * 64 + fr, col0 = u.pn * 256 + wc * 32 + 4 * fq;
        if (u.split) {
#pragma unroll
            for (int m = 0; m < 4; ++m) { const int r = wr * 64 + m * 16 + fr;
#pragma unroll
                for (int bj = 0; bj < 2; ++bj)
#pragma unroll
                    for (int n = 0; n < 2; ++n) { const int c = col0 + bj * 128 + n * 16; const u32x2 gz = *(const u32x2*)(Z + (size_t)(NPR + r) * ZW + 6144 + u.kind * 2048 + c);
                        const f32x4 a = acc[0][bj][m][n]; f32x4 v; v[0] = sigm(bflo(gz.x)) * a[0]; v[1] = sigm(bfhi(gz.x)) * a[1]; v[2] = sigm(bflo(gz.y)) * a[2]; v[3] = sigm(bfhi(gz.y)) * a[3];
                        *(f32x4*)(PART + ((size_t)u.slot * 128 + r) * DM + c) = v; } }
            return;
        }
#pragma unroll
        for (int ai = 0; ai < 2; ++ai)
#pragma unroll
            for (int mp = 0; mp < 2; ++mp) {
                u32x2 gzv[2][2][2]; f32x4 mgv[2][2][2];
#pragma unroll
                for (int mm = 0; mm < 2; ++mm)
#pragma unroll
                    for (int bj = 0; bj < 2; ++bj)
#pragma unroll
                        for (int n = 0; n < 2; ++n) { const int row = row0 + ai * 128 + (2 * mp + mm) * 16, c = col0 + bj * 128 + n * 16;
                            gzv[mm][bj][n] = *(const u32x2*)(Z + (size_t)row * ZW + 6144 + u.kind * 2048 + c);
                            mgv[mm][bj][n] = (f32x4){0.f, 0.f, 0.f, 0.f}; if (u.kind != 0) mgv[mm][bj][n] = *(const f32x4*)(MG + (size_t)row * DM + c); }
#pragma unroll
                for (int mm = 0; mm < 2; ++mm)
#pragma unroll
                    for (int bj = 0; bj < 2; ++bj)
#pragma unroll
                        for (int n = 0; n < 2; ++n) { const int m = 2 * mp + mm, row = row0 + ai * 128 + m * 16, c = col0 + bj * 128 + n * 16; const u32x2 gz = gzv[mm][bj][n];
                            const f32x4 a = acc[ai][bj][m][n]; f32x4 v; v[0] = sigm(bflo(gz.x)) * a[0]; v[1] = sigm(bfhi(gz.x)) * a[1]; v[2] = sigm(bflo(gz.y)) * a[2]; v[3] = sigm(bfhi(gz.y)) * a[3];
                            v = v + mgv[mm][bj][n];
                            float* mp_ = MG + (size_t)row * DM + c;
                            if (u.kind != 2) *(f32x4*)mp_ = v;
                            else { u32x2 w; w.x = pk2(v[0], v[1]); w.y = pk2(v[2], v[3]); *(u32x2*)(MB + (size_t)row * DM + c) = w; } }
            }
    }
};
__device__ __forceinline__ void tr_item(const float* W, int N, int K, const float* gain, bf16_t* WT, int k0, int nsrc0, int ndst0, LAS float* scr, int lane) {
    const int n4 = lane & 7, kq = lane >> 3;
    const float* src = W + (size_t)(k0 + 8 * kq) * N + nsrc0 + 4 * n4;
    f32x4 v[8];
#pragma unroll
    for (int j = 0; j < 8; ++j) v[j] = __builtin_nontemporal_load((const f32x4*)(src + (size_t)j * N));
    if (gain) {
        const f32x4 g0 = *(const f32x4*)(gain + k0 + 8 * kq), g1 = *(const f32x4*)(gain + k0 + 8 * kq + 4);
        v[0] = v[0] * g0[0]; v[1] = v[1] * g0[1]; v[2] = v[2] * g0[2]; v[3] = v[3] * g0[3]; v[4] = v[4] * g1[0]; v[5] = v[5] * g1[1]; v[6] = v[6] * g1[2]; v[7] = v[7] * g1[3];
    }
#pragma unroll
    for (int i = 0; i < 4; ++i) {
        u32x4 o; o.x = pk2(v[0][i], v[1][i]); o.y = pk2(v[2][i], v[3][i]); o.z = pk2(v[4][i], v[5][i]); o.w = pk2(v[6][i], v[7][i]);
        *(u32x4*)(WT + (size_t)(ndst0 + 4 * n4 + i) * K + k0 + 8 * kq) = o;
    }
}
constexpr int TRC_GU = 32 * 172, TRC_DN = 86 * 64, TRC_IN = 32 * 384, TRC_GL = 16 * 32, TRC_MK = 32 * 32, TRC_BR = 16 * 64, TRC_WO = 32 * 64;
constexpr int TR_NITEMS = 4 * TRC_GU + 2 * TRC_DN + TRC_IN + TRC_GL + 2 * TRC_MK + 3 * TRC_BR + TRC_WO;
__device__ __forceinline__ void tr_dispatch(const Args& a, int it, int lane) {
    unsigned char* ws = a.ws; LAS float* scr = nullptr;
    constexpr int C_GU = 32 * 172, C_DN = 86 * 64, C_IN = 32 * 384, C_GL = 16 * 32, C_MK = 32 * 32, C_BR = 16 * 64, C_WO = 32 * 64;
        int r = it;
        if (r < 4 * C_GU) { const int q = r / C_GU; r -= q * C_GU; const int kb = r / 172, nb = r % 172, ns = 32 * nb, nd = (ns >> 7) * 256 + (ns & 127) + ((q & 1) ? 128 : 0);
            tr_item(a.in[q == 0 ? I_W1G : (q == 1 ? I_W1U : (q == 2 ? I_W2G : I_W2U))], FF, DM, a.in[q < 2 ? I_GF1 : I_GF2], (bf16_t*)(ws + (q < 2 ? WS_W1GU : WS_W2GU)), 64 * kb, ns, nd, scr, lane); return; }
        r -= 4 * C_GU;
        if (r < 2 * C_DN) { const int q = r / C_DN; r -= q * C_DN; const int kb = r / 64, nb = r % 64;
            tr_item(a.in[q == 0 ? I_W1D : I_W2D], DM, FF, nullptr, (bf16_t*)(ws + (q == 0 ? WS_W1D : WS_W2D)), 64 * kb, 32 * nb, 32 * nb, scr, lane); return; }
        r -= 2 * C_DN;
        if (r < C_IN) { const int kb = r / 384, nb = r % 384, nd = 32 * nb, ns = nd + (nd >= 5120 ? 8 : 0);
            tr_item(a.in[I_WIN], 12296, DM, a.in[I_GMIX], (bf16_t*)(ws + WS_WIN), 64 * kb, ns, nd, scr, lane); return; }
        r -= C_IN;
        if (r < C_GL) { const int kb = r / 32, nb = r % 32; tr_item(a.in[I_WGLU], 1024, 1024, nullptr, (bf16_t*)(ws + WS_WGLU), 64 * kb, 32 * nb, 32 * nb, scr, lane); return; }
        r -= C_GL;
        if (r < 2 * C_MK) { const int q = r / C_MK; r -= q * C_MK; const int kb = r / 32, nb = r % 32;
            tr_item(a.in[q == 0 ? I_WMK : I_WMV], 1024, DM, a.in[I_GMEM], (bf16_t*)(ws + WS_WMEM), 64 * kb, 32 * nb, 1024 * q + 32 * nb, scr, lane); return; }
        r -= 2 * C_MK;
        if (r < 3 * C_BR) { const int q = r / C_BR; r -= q * C_BR; const int kb = r / 64, nb = r % 64;
            tr_item(a.in[q == 0 ? I_WBS5 : (q == 1 ? I_WBML : I_WBXA)], DM, 1024, nullptr, (bf16_t*)(ws + WS_WBR) + (size_t)q * DM * 1024, 64 * kb, 32 * nb, 32 * nb, scr, lane); return; }
        r -= 3 * C_BR;
        { const int kb = r / 64, nb = r % 64; tr_item(a.in[I_WOUT], DM, DM, nullptr, (bf16_t*)(ws + WS_WOUT), 64 * kb, 32 * nb, 32 * nb, scr, lane); }
}
__device__ __forceinline__ double dexp_small(double x) {
    double s = 1.0;
#pragma unroll
    for (int i = 16; i >= 1; --i) s = 1.0 + s * x * (1.0 / (double)i);
    return s;
}
__device__ __forceinline__ void p0_prologue(const Args& a, LAS unsigned char* lds) {
    const int tid = pg8::opaque_tid(), lane = tid & 63, wave = tid >> 6, G = gridDim.x;
    const int gw = blockIdx.x * 8 + wave, NGW = G * 8;
    unsigned char* ws = a.ws;
    LAS float* scr = (LAS float*)(lds + wave * 16384);
    { unsigned* ctl = (unsigned*)(ws + WS_CTL); const int gt = blockIdx.x * 512 + tid, NG = G * 512;
      for (int i = gt; i < 64; i += NG) ctl[CW_Q + i] = 0u;
      for (int i = CW_SS2 + gt; i < CW_SSM; i += NG) ctl[i] = 0u;
      for (int i = CW_HSS + gt; i < CW_END; i += NG) ctl[i] = 0u;
      bf16_t* WINp = (bf16_t*)(ws + WS_WIN) + (size_t)ZW * DM; const float* win = a.in[I_WIN]; const float* gm = a.in[I_GMIX];
      for (int i = gt; i < 256 * DM; i += NG) { const int j = i >> 11, k = i & 2047; WINp[i] = (j < 8) ? f2bf(win[(size_t)k * 12296 + 5120 + j] * gm[k]) : (bf16_t)0; }
      float* AB = (float*)(ws + WS_S5T); bf16_t* BBt = (bf16_t*)(ws + WS_S5T + 32768);
      for (int i = gt; i < 4096; i += NG) {
          const int g = i >> 6;
          const double lr = (double)a.in[I_LRE][i], li = (double)a.in[I_LIM][i], ls = (double)a.in[I_LSTEP][g];
          double dt = dexp_small(ls * (1.0 / 16.0)); dt *= dt; dt *= dt; dt *= dt; dt *= dt;
          const double mag = dexp_small(lr * dt);
          double th = li * dt; th -= 6.283185307179586476925 * rint(th * 0.15915494309189533577); const double hh = 0.5 * th, h2 = hh * hh;
          double sn = 1.0, cs = 1.0;
#pragma unroll
          for (int k = 10; k >= 1; --k) { sn = 1.0 - sn * h2 * (1.0 / (double)((2 * k) * (2 * k + 1))); cs = 1.0 - cs * h2 * (1.0 / (double)((2 * k - 1) * (2 * k))); }
          sn *= hh;
          const double sinT = 2.0 * sn * cs, cosT = 1.0 - 2.0 * sn * sn;
          const double abr = mag * cosT, abi = mag * sinT, den = lr * lr + li * li, nr = abr - 1.0;
          const double zr = (nr * lr + abi * li) / den, zi = (abi * lr - nr * li) / den;
          AB[2 * i] = (float)abr; AB[2 * i + 1] = (float)abi;
          const int p = i & 63;
#pragma unroll
          for (int h = 0; h < 16; ++h) { const double br = (double)a.in[I_BRE][(size_t)i * 16 + h], bi = (double)a.in[I_BIM][(size_t)i * 16 + h];
              BBt[((size_t)g * 128 + p) * 16 + h] = f2bf((float)(zr * br - zi * bi)); BBt[((size_t)g * 128 + 64 + p) * 16 + h] = f2bf((float)(zr * bi + zi * br)); }
      }
    }
    for (int it = gw; it < 2 * TRC_GU; it += NGW) tr_dispatch(a, it, lane);
    for (int it = 4 * TRC_GU + 2 * TRC_DN + TRC_IN + TRC_GL + gw; it < 4 * TRC_GU + 2 * TRC_DN + TRC_IN + TRC_GL + 2 * TRC_MK; it += NGW) tr_dispatch(a, it, lane);
    { bf16_t* XB = (bf16_t*)(ws + WS_XB); bf16_t* MEMB = (bf16_t*)(ws + WS_MEMB); float* ctlf = (float*)(ws + WS_CTL);
      for (int row = gw; row < MR + 1024; row += NGW) {
          const float* src; bf16_t* dst; float* sd;
          if (row < MR) { src = row < NPR ? a.in[I_XP] + (size_t)row * DM : a.in[I_XS] + (size_t)(row - NPR) * DM; dst = XB + (size_t)row * DM; sd = ctlf + CW_SS1 + row; }
          else { const int mr = row - MR; src = a.in[I_MEM] + (size_t)mr * DM; dst = MEMB + (size_t)mr * DM; sd = ctlf + CW_SSM + mr; }
          const bool real = (row < NT) || (row >= MR);
          float s = 0.f;
#pragma unroll
          for (int j = 0; j < 8; ++j) { f32x4 v = (f32x4){0.f, 0.f, 0.f, 0.f}; if (real) v = __builtin_nontemporal_load((const f32x4*)(src + 4 * (lane + 64 * j)));
              s += (v[0] * v[0] + v[1] * v[1]) + (v[2] * v[2] + v[3] * v[3]); u32x2 w; w.x = pk2(v[0], v[1]); w.y = pk2(v[2], v[3]); *(u32x2*)(dst + 4 * (lane + 64 * j)) = w; }
          s = wave_sum(s); if (lane == 0) *sd = s;
      }
    }
}
template <int MODE>
__device__ __forceinline__ void s5_wave(const Args& a, LAS unsigned char* wl, int item, int lane) {
    unsigned char* ws = a.ws;
    const bf16_t* Z = (const bf16_t*)(ws + WS_Z); bf16_t* S5Y = (bf16_t*)(ws + WS_S5Y); float* S5E = (float*)(ws + WS_S5E);
    const float* AB = (const float*)(ws + WS_S5T); const bf16_t* BBt = (const bf16_t*)(ws + WS_S5T + 32768);
    int b, g, ch = 0, nblk; size_t tok0;
    { const int it = item >> 3, w8 = item & 7, gl = w8 & 3, cl = w8 >> 2;
      if (MODE == 2) { g = 4 * (it & 15) + gl; b = 2 * (it >> 4) + cl; tok0 = (size_t)NPR + b; nblk = 1; }
      else { b = it >> 7; g = 4 * ((it & 127) >> 3) + gl; ch = 2 * (it & 7) + cl; tok0 = (size_t)b * SEQ + ch * 128; nblk = 8; } }
    const int p = lane, r16 = lane & 15, g4 = lane >> 4;
    LAS float* BU = (LAS float*)wl;
    LAS bf16_t* SB = (LAS bf16_t*)(wl + 8448);
    LAS bf16_t* UB = (LAS bf16_t*)(wl + 12800);
    const float ar = AB[(g * 64 + p) * 2], ai = AB[(g * 64 + p) * 2 + 1];
    bf16x8 bb[8];
#pragma unroll
    for (int T = 0; T < 8; ++T) { bb[T] = (bf16x8){0, 0, 0, 0, 0, 0, 0, 0}; if (g4 < 2) bb[T] = *(const bf16x8*)(BBt + ((size_t)g * 128 + 16 * T + r16) * 16 + 8 * g4); }
    bf16x8 cc[4]; float dco = 0.f;
    if (MODE != 0) {
        dco = a.in[I_S5D][g * 16 + r16];
#pragma unroll
        for (int ks = 0; ks < 4; ++ks) { const int k0 = 32 * ks + 8 * g4; const bool im = k0 >= 64;
            const float* cp = (im ? a.in[I_CIM] : a.in[I_CRE]) + ((size_t)g * 16 + r16) * 64 + (im ? k0 - 64 : k0);
            const f32x4 c0 = *(const f32x4*)cp, c1 = *(const f32x4*)(cp + 4); const float sg = im ? -1.f : 1.f;
            u32x4 w; w.x = pk2(sg * c0[0], sg * c0[1]); w.y = pk2(sg * c0[2], sg * c0[3]); w.z = pk2(sg * c1[0], sg * c1[1]); w.w = pk2(sg * c1[2], sg * c1[3]);
            cc[ks] = __builtin_bit_cast(bf16x8, w); }
    }
    float sr = 0.f, si = 0.f;
    if (MODE == 1 && ch > 0) {
        float pr = ar, pi = ai;
#pragma unroll
        for (int i = 0; i < 7; ++i) { const float t = pr * pr - pi * pi; pi = 2.f * pr * pi; pr = t; }
        float erv[15], eiv[15];
#pragma unroll
        for (int j = 0; j < 15; ++j) { erv[j] = 0.f; eiv[j] = 0.f; if (j < ch) { const float* e = S5E + ((size_t)(b * 64 + g) * 16 + j) * 128; erv[j] = e[p]; eiv[j] = e[64 + p]; } }
#pragma unroll
        for (int j = 0; j < 15; ++j) if (j < ch) { const float t = pr * sr - pi * si + erv[j]; si = pr * si + pi * sr + eiv[j]; sr = t; }
    }
    if (MODE == 2) { sr = a.in[I_S5R][(size_t)(b * 64 + g) * 64 + p]; si = a.in[I_S5I][(size_t)(b * 64 + g) * 64 + p]; }
    bf16x8 un = (bf16x8){0, 0, 0, 0, 0, 0, 0, 0};
    if (g4 < 2 && (MODE != 2 || r16 == 0)) un = *(const bf16x8*)(Z + (tok0 + r16) * ZW + g * 16 + 8 * g4);
    for (int blk = 0; blk < nblk; ++blk) {
        const size_t t0 = tok0 + 16 * blk;
        const bf16x8 ua = un;
        if (MODE != 0 && g4 < 2) *(LAS bf16x8*)(UB + r16 * 16 + 8 * g4) = ua;
        if (MODE != 2 && blk + 1 < nblk && g4 < 2) un = *(const bf16x8*)(Z + (t0 + 16 + r16) * ZW + g * 16 + 8 * g4);
#pragma unroll
        for (int T = 0; T < 8; ++T) { const f32x4 d = MFMA16(ua, bb[T], ((f32x4){0.f, 0.f, 0.f, 0.f}));
#pragma unroll
            for (int r = 0; r < 4; ++r) BU[(4 * g4 + r) * 132 + 16 * T + r16] = d[r]; }
        LDS_WAIT(); asm volatile("" ::: "memory");
        float brv[16], biv[16];
#pragma unroll
        for (int t = 0; t < 16; ++t) { if (MODE == 2 && t > 0) break; brv[t] = BU[t * 132 + p]; biv[t] = BU[t * 132 + 64 + p]; }
#pragma unroll
        for (int t = 0; t < 16; ++t) {
            if (MODE == 2 && t > 0) break;
            const float br = brv[t], bi = biv[t];
            const float nr = ar * sr - ai * si + br; si = ar * si + ai * sr + bi; sr = nr;
            if (MODE != 0) { SB[t * 136 + p] = f2bf(sr); SB[t * 136 + 64 + p] = f2bf(si); }
        }
        LDS_WAIT(); asm volatile("" ::: "memory");
        if (MODE != 0) {
            f32x4 y = (f32x4){0.f, 0.f, 0.f, 0.f};
#pragma unroll
            for (int ks = 0; ks < 4; ++ks) { const bf16x8 af = *(const LAS bf16x8*)(SB + r16 * 136 + 32 * ks + 8 * g4); y = MFMA16(af, cc[ks], y); }
#pragma unroll
            for (int r = 0; r < 4; ++r) { const int t = 4 * g4 + r;
                if (MODE != 2 || t == 0) { const float uu = bf2f(UB[t * 16 + r16]); S5Y[(t0 + t) * 1024 + g * 16 + r16] = f2bf(gelu_t(y[r] + dco * uu)); } }
            LDS_WAIT(); asm volatile("" ::: "memory");
        }
    }
    if (MODE == 0) { float* e = S5E + ((size_t)(b * 64 + g) * 16 + ch) * 128; e[p] = sr; e[64 + p] = si; }
    if (MODE == 1 && ch == 15) { a.out[O_S5RP + (size_t)(b * 64 + g) * 64 + p] = sr; a.out[O_S5IP + (size_t)(b * 64 + g) * 64 + p] = si; }
    if (MODE == 2) { a.out[O_S5RS + (size_t)(b * 64 + g) * 64 + p] = sr; a.out[O_S5IS + (size_t)(b * 64 + g) * 64 + p] = si; }
}

__device__ __forceinline__ void xatt_prompt(const Args& a, LAS unsigned char* lds, int item) {
    unsigned char* ws = a.ws;
    const bf16_t* Z = (const bf16_t*)(ws + WS_Z); const bf16_t* MKB = (const bf16_t*)(ws + WS_MKB); const bf16_t* MVT = (const bf16_t*)(ws + WS_MVT); bf16_t* XAO = (bf16_t*)(ws + WS_XAO);
    const int tid = pg8::opaque_tid(), lane = tid & 63, w = tid >> 6, r16 = lane & 15, g4 = lane >> 4;
    const int b = item >> 6, h = (item >> 4) & 3, qb = item & 15;
    const size_t tokw = (size_t)b * SEQ + qb * 128 + w * 16;
    LAS bf16_t* Pw = (LAS bf16_t*)(lds + w * 8448);
    bf16x8 qf[8];
#pragma unroll
    for (int ks = 0; ks < 8; ++ks) qf[ks] = *(const bf16x8*)(Z + (tokw + r16) * ZW + 5120 + h * 256 + 32 * ks + 8 * g4);
    f32x4 s[16];
#pragma unroll
    for (int kt = 0; kt < 16; ++kt) { s[kt] = (f32x4){0.f, 0.f, 0.f, 0.f};
        const bf16_t* kp = MKB + ((size_t)(b * 256 + 16 * kt + r16)) * 1024 + h * 256 + 8 * g4;
#pragma unroll
        for (int ks = 0; ks < 8; ++ks) s[kt] = MFMA16(qf[ks], *(const bf16x8*)(kp + 32 * ks), s[kt]); }
    float rs[4];
#pragma unroll
    for (int r = 0; r < 4; ++r) {
        float mx = s[0][r];
#pragma unroll
        for (int kt = 1; kt < 16; ++kt) mx = fmaxf(mx, s[kt][r]);
        mx = fmaxf(mx, __shfl_xor(mx, 1)); mx = fmaxf(mx, __shfl_xor(mx, 2)); mx = fmaxf(mx, __shfl_xor(mx, 4)); mx = fmaxf(mx, __shfl_xor(mx, 8));
        float sm = 0.f;
#pragma unroll
        for (int kt = 0; kt < 16; ++kt) { const float e = __expf((s[kt][r] - mx) * 0.0625f); sm += e; Pw[(4 * g4 + r) * 264 + 16 * kt + r16] = f2bf(e); }
        sm += __shfl_xor(sm, 1); sm += __shfl_xor(sm, 2); sm += __shfl_xor(sm, 4); sm += __shfl_xor(sm, 8);
        rs[r] = 1.0f / sm;
    }
    LDS_WAIT(); asm volatile("" ::: "memory");
    bf16x8 pf[8];
#pragma unroll
    for (int ks = 0; ks < 8; ++ks) pf[ks] = *(const LAS bf16x8*)(Pw + r16 * 264 + 32 * ks + 8 * g4);
#pragma unroll 4
    for (int dt = 0; dt < 16; ++dt) { f32x4 o = (f32x4){0.f, 0.f, 0.f, 0.f};
        const bf16_t* vp = MVT + ((size_t)((b * 4 + h) * 256 + 16 * dt + r16)) * 256 + 8 * g4;
#pragma unroll
        for (int ks = 0; ks < 8; ++ks) o = MFMA16(pf[ks], *(const bf16x8*)(vp + 32 * ks), o);
#pragma unroll
        for (int r = 0; r < 4; ++r) XAO[(tokw + 4 * g4 + r) * 1024 + h * 256 + 16 * dt + r16] = f2bf(o[r] * rs[r]); }
    LDS_WAIT(); asm volatile("" ::: "memory");
}

__device__ __forceinline__ void xatt_sample(const Args& a, LAS unsigned char* lds, int item) {
    unsigned char* ws = a.ws;
    const bf16_t* Z = (const bf16_t*)(ws + WS_Z); bf16_t* XAO = (bf16_t*)(ws + WS_XAO);
    const int tid = pg8::opaque_tid(), lane = tid & 63, w = tid >> 6;
    const int b = item >> 2, h = item & 3; const size_t tok = (size_t)NPR + b;
    LAS float* sc = (LAS float*)lds; LAS float* pl = sc + 256; LAS float* part = sc + 512;
    const u32x2 qz = *(const u32x2*)(Z + tok * ZW + 5120 + h * 256 + 4 * lane);
    const float q0 = bflo(qz.x) * 0.0625f, q1 = bfhi(qz.x) * 0.0625f, q2 = bflo(qz.y) * 0.0625f, q3 = bfhi(qz.y) * 0.0625f;
    const float* Kc = a.in[I_CK] + ((size_t)b * 256 * 4 + h) * 256 + 4 * lane;
    const float* Vc = a.in[I_CV] + ((size_t)b * 256 * 4 + h) * 256 + 4 * lane;
    float myscore = 0.f;
#pragma unroll 8
    for (int kk = 0; kk < 32; ++kk) { const f32x4 kv = __builtin_nontemporal_load((const f32x4*)(Kc + (size_t)(32 * w + kk) * 1024));
        float d = (q0 * kv[0] + q1 * kv[1]) + (q2 * kv[2] + q3 * kv[3]); d = wave_sum(d); if (lane == kk) myscore = d; }
    if (lane < 32) sc[32 * w + lane] = myscore;
    __syncthreads();
    { const float v0 = sc[lane], v1 = sc[lane + 64], v2 = sc[lane + 128], v3 = sc[lane + 192];
      const float mx = wave_max(fmaxf(fmaxf(v0, v1), fmaxf(v2, v3)));
      const float e0 = __expf(v0 - mx), e1 = __expf(v1 - mx), e2 = __expf(v2 - mx), e3 = __expf(v3 - mx);
      const float inv = 1.0f / wave_sum((e0 + e1) + (e2 + e3));
      if (w == 0) { pl[lane] = e0 * inv; pl[lane + 64] = e1 * inv; pl[lane + 128] = e2 * inv; pl[lane + 192] = e3 * inv; } }
    __syncthreads();
    f32x4 acc = (f32x4){0.f, 0.f, 0.f, 0.f};
#pragma unroll 8
    for (int kk = 0; kk < 32; ++kk) { const f32x4 vv = __builtin_nontemporal_load((const f32x4*)(Vc + (size_t)(32 * w + kk) * 1024)); acc = acc + vv * pl[32 * w + kk]; }
    *(LAS f32x4*)(part + w * 256 + 4 * lane) = acc;
    __syncthreads();
    if (tid < 256) { float o = 0.f;
#pragma unroll
        for (int i = 0; i < 8; ++i) o += part[i * 256 + tid];
        XAO[tok * 1024 + h * 256 + tid] = f2bf(o); }
}

__device__ __forceinline__ float logsig(float x) { return fminf(x, 0.f) - __logf(1.0f + __expf(-fabsf(x))); }
__device__ __forceinline__ void mlstm_sample(const Args& a, LAS unsigned char* lds, int item) {
    unsigned char* ws = a.ws;
    const bf16_t* Z = (const bf16_t*)(ws + WS_Z); const float* IF = (const float*)(ws + WS_IF); bf16_t* MLO = (bf16_t*)(ws + WS_MLO);
    const int tid = pg8::opaque_tid(), lane = tid & 63, w = tid >> 6;
    const int b = item >> 2, h = item & 3; const size_t tok = (size_t)NPR + b; const size_t bh = (size_t)b * 4 + h;
    LAS float* qs = (LAS float*)lds; LAS float* ks = qs + 256; LAS float* vs = qs + 512; LAS float* part = qs + 768; LAS float* red = qs + 768 + 2048;
    if (tid < 256) { qs[tid] = bf2f(Z[tok * ZW + 1024 + h * 256 + tid]); ks[tid] = bf2f(Z[tok * ZW + 2048 + h * 256 + tid]) * 0.0625f; vs[tid] = bf2f(Z[tok * ZW + 3072 + h * 256 + tid]); }
    const float ipre = IF[tok * 8 + h] + a.in[I_BI][h], fpre = IF[tok * 8 + 4 + h] + a.in[I_BF][h];
    const float m0 = a.in[I_MM][bh], gi = logsig(fpre) + m0, mt = fmaxf(gi, ipre), wi = __expf(gi - mt), wa = __expf(ipre - mt);
    const float* n0 = a.in[I_MN] + bh * 256;
    __syncthreads();
    float qk, qn;
    { const f32x4 q4 = *(const LAS f32x4*)(qs + 4 * lane), k4 = *(const LAS f32x4*)(ks + 4 * lane), n4 = *(const f32x4*)(n0 + 4 * lane);
      qk = wave_sum((q4[0] * k4[0] + q4[1] * k4[1]) + (q4[2] * k4[2] + q4[3] * k4[3])); qn = wave_sum((q4[0] * n4[0] + q4[1] * n4[1]) + (q4[2] * n4[2] + q4[3] * n4[3])); }
    const float sv = qk * wa;
    const f32x4 vv = *(const LAS f32x4*)(vs + 4 * lane);
    const float* C0 = a.in[I_MC] + bh * 65536 + 4 * lane; float* C1 = a.out + O_CS + bh * 65536 + 4 * lane;
    f32x4 acc = (f32x4){0.f, 0.f, 0.f, 0.f};
#pragma unroll 8
    for (int r = 0; r < 32; ++r) { const int dk = 32 * w + r; const f32x4 c = __builtin_nontemporal_load((const f32x4*)(C0 + (size_t)dk * 256)); const float qd = qs[dk], kd = ks[dk] * wa;
        acc = acc + c * qd; __builtin_nontemporal_store(c * wi + vv * kd, (f32x4*)(C1 + (size_t)dk * 256)); }
    *(LAS f32x4*)(part + w * 256 + 4 * lane) = acc;
    __syncthreads();
    float hval = 0.f;
    if (tid < 256) { float qc = 0.f;
#pragma unroll
        for (int i = 0; i < 8; ++i) qc += part[i * 256 + tid];
        const float num = sv * vs[tid] + wi * qc, nq = sv + wi * qn, den = fmaxf(fabsf(nq), __expf(-mt));
        hval = num / den;
        a.out[O_NS + bh * 256 + tid] = wi * n0[tid] + wa * ks[tid];
        if (tid == 0) a.out[O_MS + bh] = mt; }
    const float sq = wave_sum(hval * hval); if (lane == 0) red[w] = sq;
    __syncthreads();
    if (tid < 256) { const float ssq = (red[0] + red[1]) + (red[2] + red[3]); const float rstd = rsqrtf(ssq * (1.0f / 256.0f) + EPS);
        const float o = bf2f(Z[tok * ZW + 4096 + h * 256 + tid]);
        MLO[tok * 1024 + h * 256 + tid] = f2bf(hval * rstd * a.in[I_GHEAD][h * 256 + tid] * sigm(o)); }
}
__device__ __forceinline__ void mlstm_prompt(const Args& a, LAS unsigned char* L, int item) {
    unsigned char* ws = a.ws;
    const bf16_t* Z = (const bf16_t*)(ws + WS_Z); const float* IF = (const float*)(ws + WS_IF); float* MLH = (float*)(ws + WS_MLH); float* HSSP = (float*)(ws + WS_HSSP);
    const int tid = pg8::opaque_tid(), lane = tid & 63, w = tid >> 6, r16 = lane & 15, g4 = lane >> 4;
    const int b = item >> 5, h = (item >> 3) & 3, j = item & 7;
    LAS bf16_t* Ks = (LAS bf16_t*)L; LAS bf16_t* Vt = (LAS bf16_t*)(L + 33792); LAS bf16_t* VtW = (LAS bf16_t*)(L + 40704); LAS bf16_t* Ct = (LAS bf16_t*)(L + 47616);
    LAS bf16_t* Ss = (LAS bf16_t*)(L + 72960); LAS float* NQ = (LAS float*)(L + 85248); LAS float* GA = (LAS float*)(L + 85504);
    const size_t tokb = (size_t)b * SEQ;
    const bf16_t* Zq = Z + 1024 + h * 256; const bf16_t* Zk = Z + 2048 + h * 256; const bf16_t* Zv = Z + 3072 + h * 256 + 32 * j;
    const int tr = w >> 1, tcv = w & 1; const bool ones = (w & 1) == 0;
    for (int i = tid; i < 48 * 264 / 2; i += 512) ((LAS unsigned*)Ct)[i] = 0u;
    for (int i = tid; i < 16 * 72; i += 512) { Vt[32 * 72 + i] = (i < 72) ? (bf16_t)0x3F80 : (bf16_t)0; VtW[32 * 72 + i] = 0; }
    f32x4 Cacc[2][3];
#pragma unroll
    for (int i = 0; i < 2; ++i)
#pragma unroll
        for (int c = 0; c < 3; ++c) Cacc[i][c] = (f32x4){0.f, 0.f, 0.f, 0.f};
    u32x4 kreg[4]; u32x4 vreg = (u32x4){0u, 0u, 0u, 0u}; bf16x8 qf[8];
    const float bi_h = a.in[I_BI][h], bf_h = a.in[I_BF][h];
#define ML_LOADKV(c) do { const size_t t0_ = tokb + 64 * (c); \
        _Pragma("unroll") for (int i_ = 0; i_ < 4; ++i_) { const int pp = tid + 512 * i_; kreg[i_] = *(const u32x4*)(Zk + (t0_ + (pp >> 5)) * ZW + 8 * (pp & 31)); } \
        if (tid < 256) vreg = *(const u32x4*)(Zv + (t0_ + (tid >> 2)) * ZW + 8 * (tid & 3)); } while (0)
#define ML_LOADQ(c) do { const size_t t0_ = tokb + 64 * (c) + 16 * tr + r16; \
        _Pragma("unroll") for (int ks_ = 0; ks_ < 8; ++ks_) qf[ks_] = *(const bf16x8*)(Zq + t0_ * ZW + 32 * ks_ + 8 * g4); } while (0)
    ML_LOADKV(0); ML_LOADQ(0);
#pragma unroll 1
    for (int cc = w; cc < 32; cc += 8) { LAS float* Gc = GA + cc * 384; const size_t t_ = tokb + 64 * cc + lane;
        float bc = logsig(IF[t_ * 8 + 4 + h] + bf_h); const float ipre = IF[t_ * 8 + h] + bi_h;
#pragma unroll
        for (int o = 1; o < 64; o <<= 1) { const float t = __shfl_up(bc, o); if (lane >= o) bc += t; }
        const float av = ipre - bc; float am = av;
#pragma unroll
        for (int o = 1; o < 64; o <<= 1) { const float t = __shfl_up(am, o); if (lane >= o) am = fmaxf(am, t); }
        Gc[lane] = bc; Gc[64 + lane] = av; Gc[128 + lane] = am; if (lane == 63) { Gc[320] = bc; Gc[321] = am; } }
    __syncthreads();
    if (tid == 0) { float m = 0.f;
        for (int cc = 0; cc < 32; ++cc) { LAS float* Gc = GA + cc * 384; const float B = Gc[320], AM = Gc[321]; Gc[322] = m; m = fmaxf(B + m, B + AM); }
        GA[323] = m; }
    __syncthreads();
#pragma unroll 1
    for (int cc = w; cc < 32; cc += 8) { LAS float* Gc = GA + cc * 384;
        const float bc = Gc[lane], av = Gc[64 + lane], am = Gc[128 + lane], B63 = Gc[320], AM63 = Gc[321], mp = Gc[322];
        const float gi = bc + mp, mt = fmaxf(gi, bc + am), mt63 = fmaxf(B63 + mp, B63 + AM63);
        Gc[lane] = bc - mt; Gc[128 + lane] = __expf(gi - mt); Gc[192 + lane] = __expf(B63 + av - mt63) * 0.0625f; Gc[256 + lane] = __expf(-mt);
        if (lane == 0) Gc[320] = __expf(B63 + mp - mt63); }
    __syncthreads();
    for (int c = 0; c < 32; ++c) {
        const LAS float* Gc = GA + c * 384;
#pragma unroll
        for (int i = 0; i < 4; ++i) { const int pp = tid + 512 * i; *(LAS u32x4*)(Ks + (pp >> 5) * 264 + 8 * (pp & 31)) = kreg[i]; }
        if (tid < 256) { const int s = tid >> 2, vq = tid & 3; const float wl = Gc[192 + s];
            const unsigned vw[4] = {vreg.x, vreg.y, vreg.z, vreg.w};
#pragma unroll
            for (int e = 0; e < 4; ++e) { const unsigned short lo = (unsigned short)(vw[e] & 0xffffu), hi = (unsigned short)(vw[e] >> 16);
                Vt[(8 * vq + 2 * e) * 72 + s] = lo; Vt[(8 * vq + 2 * e + 1) * 72 + s] = hi;
                VtW[(8 * vq + 2 * e) * 72 + s] = f2bf(bf2f(lo) * wl * 16.0f * 0.0625f); VtW[(8 * vq + 2 * e + 1) * 72 + s] = f2bf(bf2f(hi) * wl * 16.0f * 0.0625f); } }
        if (tid < 64) VtW[32 * 72 + tid] = f2bf(Gc[192 + tid]);
        if (c + 1 < 32) ML_LOADKV(c + 1);
        __syncthreads();
#pragma unroll
        for (int tt = 0; tt < 2; ++tt) { const int tc = 2 * (w & 1) + tt; f32x4 sacc = (f32x4){0.f, 0.f, 0.f, 0.f};
#pragma unroll
            for (int ks = 0; ks < 8; ++ks) sacc = MFMA16(qf[ks], *(const LAS bf16x8*)(Ks + (16 * tc + r16) * 264 + 32 * ks + 8 * g4), sacc);
            const int s = 16 * tc + r16; const float ga = Gc[64 + s];
#pragma unroll
            for (int r = 0; r < 4; ++r) { const int t = 16 * tr + 4 * g4 + r; const float wgt = (s <= t) ? __expf(Gc[t] + ga) * 0.0625f : 0.f; Ss[t * 72 + s] = f2bf(sacc[r] * wgt); } }
        f32x4 oacc[2];
#pragma unroll
        for (int q = 0; q < 2; ++q) { oacc[q] = (f32x4){0.f, 0.f, 0.f, 0.f};
            if (q == 0 || ones) { const int ct = (q == 0) ? tcv : 2;
#pragma unroll
                for (int ks = 0; ks < 8; ++ks) oacc[q] = MFMA16(qf[ks], *(const LAS bf16x8*)(Ct + (16 * ct + r16) * 264 + 32 * ks + 8 * g4), oacc[q]);
#pragma unroll
                for (int r = 0; r < 4; ++r) oacc[q][r] *= Gc[128 + 16 * tr + 4 * g4 + r]; } }
        if (c + 1 < 32) ML_LOADQ(c + 1);
        __syncthreads();
#pragma unroll
        for (int q = 0; q < 2; ++q) if (q == 0 || ones) { const int ct = (q == 0) ? tcv : 2;
#pragma unroll
            for (int ks = 0; ks < 2; ++ks) oacc[q] = MFMA16(*(const LAS bf16x8*)(Ss + (16 * tr + r16) * 72 + 32 * ks + 8 * g4), *(const LAS bf16x8*)(Vt + (16 * ct + r16) * 72 + 32 * ks + 8 * g4), oacc[q]); }
        if (ones && r16 == 0) {
#pragma unroll
            for (int r = 0; r < 4; ++r) NQ[16 * tr + 4 * g4 + r] = oacc[1][r]; }
        { const float wC = Gc[320];
#pragma unroll
          for (int i = 0; i < 2; ++i) { const int db = 2 * w + i;
              bf16x8 af[2];
#pragma unroll
              for (int ks = 0; ks < 2; ++ks) { bf16x8 t;
#pragma unroll
                  for (int e = 0; e < 8; ++e) t[e] = (short)Ks[(32 * ks + 8 * g4 + e) * 264 + 16 * db + r16];
                  af[ks] = t; }
#pragma unroll
              for (int ct = 0; ct < 3; ++ct) { f32x4 cv = Cacc[i][ct] * wC;
#pragma unroll
                  for (int ks = 0; ks < 2; ++ks) cv = MFMA16(af[ks], *(const LAS bf16x8*)(VtW + (16 * ct + r16) * 72 + 32 * ks + 8 * g4), cv);
                  Cacc[i][ct] = cv;
                  u32x2 wv; wv.x = pk2(cv[0], cv[1]); wv.y = pk2(cv[2], cv[3]); *(LAS u32x2*)(Ct + (16 * ct + r16) * 264 + 16 * db + 4 * g4) = wv; } } }
        __syncthreads();
        { float* op = MLH + (tokb + 64 * c + 16 * tr + 4 * g4) * 1024 + h * 256 + 32 * j + 16 * tcv + r16;
#pragma unroll
          for (int r = 0; r < 4; ++r) { const int t = 16 * tr + 4 * g4 + r; const float hv = oacc[0][r] / fmaxf(fabsf(NQ[t]), Gc[256 + t]); op[(size_t)r * 1024] = hv;
              float sq = hv * hv; sq += __shfl_xor(sq, 1); sq += __shfl_xor(sq, 2); sq += __shfl_xor(sq, 4); sq += __shfl_xor(sq, 8);
              if (r16 == 0) HSSP[((size_t)(2 * j + tcv) * 4 + h) * NPR + tokb + 64 * c + t] = sq; } }
    }
    { float* Cp = a.out + O_CP + ((size_t)(b * 4 + h) * 256) * 256 + 32 * j;
#pragma unroll
      for (int i = 0; i < 2; ++i)
#pragma unroll
          for (int r = 0; r < 4; ++r) { const int d = 16 * (2 * w + i) + 4 * g4 + r;
              Cp[(size_t)d * 256 + r16] = Cacc[i][0][r]; Cp[(size_t)d * 256 + 16 + r16] = Cacc[i][1][r];
              if (j == 0 && r16 == 0) a.out[O_NP + (size_t)(b * 4 + h) * 256 + d] = Cacc[i][2][r]; }
      if (j == 0 && tid == 0) a.out[O_MP + b * 4 + h] = GA[323]; }
#undef ML_LOADKV
#undef ML_LOADQ
}

__device__ __forceinline__ void mlnorm_rows4(const Args& a, int tok0, int tstride, int lane) {
    unsigned char* ws = a.ws;
    const float* MLH = (const float*)(ws + WS_MLH); const float* HSSP = (const float*)(ws + WS_HSSP); const bf16_t* Z = (const bf16_t*)(ws + WS_Z); bf16_t* MLO = (bf16_t*)(ws + WS_MLO);
    const int hh = lane >> 4, sl = lane & 15, c0 = 16 * lane;
    f32x4 gh[4];
#pragma unroll
    for (int q = 0; q < 4; ++q) gh[q] = *(const f32x4*)(a.in[I_GHEAD] + c0 + 4 * q);
    float hs[4]; f32x4 hv[4][4]; u32x4 oz[4][2]; bool ok[4];
#pragma unroll
    for (int k = 0; k < 4; ++k) { const int tok = tok0 + k * tstride; ok[k] = tok < NPR; const size_t t = ok[k] ? tok : 0;
        hs[k] = HSSP[((size_t)sl * 4 + hh) * NPR + t];
#pragma unroll
        for (int q = 0; q < 4; ++q) hv[k][q] = *(const f32x4*)(MLH + t * 1024 + c0 + 4 * q);
        oz[k][0] = *(const u32x4*)(Z + t * ZW + 4096 + c0); oz[k][1] = *(const u32x4*)(Z + t * ZW + 4096 + c0 + 8); }
#pragma unroll
    for (int k = 0; k < 4; ++k) {
        float h = hs[k]; h += __shfl_xor(h, 1); h += __shfl_xor(h, 2); h += __shfl_xor(h, 4); h += __shfl_xor(h, 8);
        const float rstd = rsqrtf(h * (1.0f / 256.0f) + EPS);
        const unsigned ow[8] = {oz[k][0].x, oz[k][0].y, oz[k][0].z, oz[k][0].w, oz[k][1].x, oz[k][1].y, oz[k][1].z, oz[k][1].w};
        unsigned pw[8];
#pragma unroll
        for (int q = 0; q < 4; ++q) { const f32x4 v = hv[k][q] * rstd * gh[q];
            pw[2 * q] = pk2(v[0] * sigm(bflo(ow[2 * q])), v[1] * sigm(bfhi(ow[2 * q]))); pw[2 * q + 1] = pk2(v[2] * sigm(bflo(ow[2 * q + 1])), v[3] * sigm(bfhi(ow[2 * q + 1]))); }
        if (ok[k]) { const size_t t = tok0 + k * tstride; u32x4 w0, w1; w0.x = pw[0]; w0.y = pw[1]; w0.z = pw[2]; w0.w = pw[3]; w1.x = pw[4]; w1.y = pw[5]; w1.z = pw[6]; w1.w = pw[7];
            *(u32x4*)(MLO + t * 1024 + c0) = w0; *(u32x4*)(MLO + t * 1024 + c0 + 8) = w1; } }
}

template <int MODE>
__device__ __forceinline__ void finalize_rows(const Args& a, int nslots, float* ssdst) {
    unsigned char* ws = a.ws; const float* PART = (const float*)(ws + WS_PART); float* X = (float*)(ws + WS_X); bf16_t* XB = (bf16_t*)(ws + WS_XB); bf16_t* MB = (bf16_t*)(ws + WS_MB);
    const int tid = pg8::opaque_tid(), lane = tid & 63, wave = tid >> 6;
    for (int r = blockIdx.x * 8 + wave; r < NSM; r += gridDim.x * 8) { const size_t row = (size_t)NPR + r; float sq = 0.f;
#pragma unroll
        for (int q = 0; q < 8; ++q) { const int cc = 4 * (lane + 64 * q); f32x4 acc = (f32x4){0.f, 0.f, 0.f, 0.f};
            for (int sl = 0; sl < nslots; ++sl) acc = acc + *(const f32x4*)(PART + ((size_t)sl * 128 + r) * DM + cc);
            if (MODE == 3) { u32x2 w; w.x = pk2(acc[0], acc[1]); w.y = pk2(acc[2], acc[3]); *(u32x2*)(MB + row * DM + cc) = w; }
            else { const f32x4 v = (MODE == 0) ? *(const f32x4*)(a.in[I_XS] + (size_t)r * DM + cc) + acc * 0.5f : *(const f32x4*)(X + row * DM + cc) + acc;
                *(f32x4*)(X + row * DM + cc) = v; u32x2 w; w.x = pk2(v[0], v[1]); w.y = pk2(v[2], v[3]); *(u32x2*)(XB + row * DM + cc) = w;
                sq += (v[0] * v[0] + v[1] * v[1]) + (v[2] * v[2] + v[3] * v[3]); } }
        if (MODE != 3) { sq = wave_sum(sq); if (lane == 0) ssdst[row] = sq; } }
}
#define XB_TMO      128
#define XB_XCNT(j)  (256  + 64 * (j))
#define XB_XSUB(j)  (1280 + 64 * (j))
#define XB_XGEN(j)  (2304 + 64 * (j))
#define XB_TOP      3328
#define XB_TOPGEN   3392
#define XCD_BAR_WORDS 3456
#define XB_SPIN_CAP (1u << 18)

__device__ __forceinline__ unsigned xb_ld(unsigned* p)              { return __hip_atomic_load(p, __ATOMIC_RELAXED, __HIP_MEMORY_SCOPE_AGENT); }
__device__ __forceinline__ unsigned xb_add(unsigned* p, unsigned v) { return __hip_atomic_fetch_add(p, v, __ATOMIC_RELAXED, __HIP_MEMORY_SCOPE_AGENT); }
__device__ __forceinline__ unsigned xb_xcc_id() { return (unsigned)__builtin_amdgcn_s_getreg((3 << 11) | 20) & 0xFu; }
#define XB_SPIN(cond, bar) do { unsigned _sp = 0; while (cond) { __builtin_amdgcn_s_sleep(1); \
    if ((++_sp & 255u) == 0u) { if (xb_ld(&(bar)[XB_TMO])) break; if (_sp > XB_SPIN_CAP) { atomicAdd(&(bar)[XB_TMO], 1u); break; } } } } while (0)

struct XcdBarrier {
    unsigned* bar; unsigned x;
    volatile LAS unsigned* st;
};

__device__ __forceinline__ XcdBarrier xcd_barrier_post(unsigned* bar, volatile LAS unsigned* st) {
    XcdBarrier b; b.bar = bar; b.x = xb_xcc_id(); b.st = st;
    if (threadIdx.x == 0) (void)xb_add(&bar[XB_XCNT(b.x)], 1u);
    return b;
}
__device__ __forceinline__ void xcd_barrier_complete(unsigned* bar, unsigned x, unsigned& nloc, unsigned& nx) {
    const unsigned G = gridDim.x * gridDim.y * gridDim.z;
    unsigned sum, cnt, mine, sp = 0u;
    for (;;) {
        sum = 0u; cnt = 0u; mine = 0u;
#pragma unroll
        for (unsigned j = 0; j < 16; ++j) { const unsigned c = xb_ld(&bar[XB_XCNT(j)]); sum += c; cnt += (c > 0u) ? 1u : 0u; mine = (j == x) ? c : mine; }
        if (sum == G) break;
        __builtin_amdgcn_s_sleep(1);
        if ((++sp & 255u) == 0u) { if (xb_ld(&bar[XB_TMO])) break; if (sp > XB_SPIN_CAP) { atomicAdd(&bar[XB_TMO], 1u); break; } }
    }
    nloc = mine > 0u ? mine : 1u; nx = cnt > 0u ? cnt : 1u;
}

__device__ __forceinline__ void xcd_barrier(const XcdBarrier& b) {
    asm volatile("s_waitcnt vmcnt(0)" ::: "memory");
    __syncthreads();
    if (threadIdx.x == 0) {
        unsigned* bar = b.bar;
        __builtin_amdgcn_s_waitcnt(0);
        unsigned nloc = b.st[0], nx = b.st[1];
        if (nloc == 0u) { xcd_barrier_complete(bar, b.x, nloc, nx); b.st[0] = nloc; b.st[1] = nx; }
        const unsigned old = xb_add(&bar[XB_XSUB(b.x)], 1u);
        const unsigned gen = old / nloc;
        if (old + 1u == (gen + 1u) * nloc) {
            __builtin_amdgcn_fence(__ATOMIC_RELEASE, "agent");
            asm volatile("s_waitcnt vmcnt(0)" ::: "memory");
            const unsigned og = xb_add(&bar[XB_TOP], 1u);
            const unsigned tg = og / nx;
            if (og + 1u == (tg + 1u) * nx) xb_add(&bar[XB_TOPGEN], 1u);
            else XB_SPIN(xb_ld(&bar[XB_TOPGEN]) == tg, bar);
            __builtin_amdgcn_fence(__ATOMIC_ACQUIRE, "agent");
            xb_add(&bar[XB_XGEN(b.x)], 1u);
            asm volatile("s_waitcnt vmcnt(0)" ::: "memory");
        } else {
            XB_SPIN(xb_ld(&bar[XB_XGEN(b.x)]) == gen, bar);
            __builtin_amdgcn_fence(__ATOMIC_ACQUIRE, "agent");
            asm volatile("s_waitcnt vmcnt(0)" ::: "memory");
        }
    }
    __syncthreads();
}
#define QLOOP0(ctr, limit, BODY) do { volatile LAS int* slot_ = (volatile LAS int*)(lds + LDS_MISC); \
        for (;;) { __syncthreads(); if (threadIdx.x == 0) *slot_ = (int)atomicAdd((ctr), 1u); __syncthreads(); const int it = *slot_; if (it >= (limit)) break; BODY; } } while (0)
#define QLOOP(ctr, limit, BODY) do { volatile LAS int* slot_ = (volatile LAS int*)(lds + LDS_MISC); int tk_ = 0; \
        if (threadIdx.x == 0) tk_ = (int)atomicAdd((ctr), 1u); \
        for (;;) { __syncthreads(); if (threadIdx.x == 0) *slot_ = tk_; __syncthreads(); const int it = *slot_; if (it >= (limit)) break; \
            if (threadIdx.x == 0) tk_ = (int)atomicAdd((ctr), 1u); \
            BODY; } } while (0)
__global__ void __launch_bounds__(512, 2) hybrid_fwd(Args a) {
    extern __shared__ __attribute__((aligned(16))) unsigned char lds_raw[];
    LAS unsigned char* lds = (LAS unsigned char*)lds_raw;
    cg::grid_group grid = cg::this_grid();
    unsigned char* ws = a.ws;
    const int G = gridDim.x, c = blockIdx.x;
    float* ctlf = (float*)(ws + WS_CTL); unsigned* ctlu = (unsigned*)(ws + WS_CTL);
    if (threadIdx.x < 2) ((volatile LAS unsigned*)(lds + LDS_MISC + 16))[threadIdx.x] = 0u;
    __syncthreads();
    bf16_t* XB = (bf16_t*)(ws + WS_XB); bf16_t* H = (bf16_t*)(ws + WS_H); float* X = (float*)(ws + WS_X); bf16_t* Z = (bf16_t*)(ws + WS_Z);
    constexpr size_t TS2048 = 256 * 2048 * 2, TS5504 = (size_t)256 * 5504 * 2, TS1024 = 256 * 1024 * 2;

#define GSYNC_CG() do { asm volatile("s_waitcnt vmcnt(0) lgkmcnt(0)" ::: "memory"); grid.sync(); \
    if (threadIdx.x == 0) { __builtin_amdgcn_fence(__ATOMIC_ACQUIRE, "agent"); asm volatile("s_waitcnt vmcnt(0)" ::: "memory"); } __syncthreads(); } while (0)
#define GSYNC() xcd_barrier(xbar)
#ifndef PHMASK
#define PHMASK 0xFFFF
#endif
#define PH(n) if constexpr (((PHMASK) >> (n)) & 1)
    const XcdBarrier xbar = xcd_barrier_post(ctlu + CW_BAR, (volatile LAS unsigned*)(lds + LDS_MISC + 16));
    PH(0) p0_prologue(a, lds);
    GSYNC();
    PH(1) { pg8::Order S{(const char*)XB, (const char*)(ws + WS_W1GU), (long)WS_MEMB - (long)WS_XB, (long)WS_WMEM - (long)WS_W1GU, 33, 43, 4 - 33, 8 - 43, 33 * 43, 33 * 43 + 32, 1, G, c, TS2048, 32, 0, 1, 1, 32};
      EpiGU E{H, ctlf + CW_SS1, ctlf + CW_SSM, a.out + O_MK, a.out + O_MV, (bf16_t*)(ws + WS_MKB), (bf16_t*)(ws + WS_MVT)};
      pg8::gemm_phase<EpiGU, pg8::Order, true, true>(lds, pg8::Gemm{DM}, S, E);
      { const int tidt = pg8::opaque_tid(), lane = tidt & 63, wave = tidt >> 6;
        QLOOP(ctlu + CW_Q + 6, TRC_DN / 8, tr_dispatch(a, 4 * TRC_GU + it * 8 + wave, lane)); } }
    GSYNC();
    PH(2) { pg8::Order S{(const char*)H, (const char*)(ws + WS_W1D), 0, 0, 32, 8, 0, 0, 256, 256, 1, G, c, TS5504, 86, 64, 8, 43, 32};
      EpiRes<0> E{a.in[I_XP], a.in[I_XS], X, XB, ctlf + CW_SS2, (float*)(ws + WS_PART)};
      pg8::gemm_phase<EpiRes<0>, pg8::Order, true, true>(lds, pg8::Gemm{FF}, S, E);
      { const int tidt = pg8::opaque_tid(), lane = tidt & 63, wave = tidt >> 6;
        QLOOP(ctlu + CW_Q + 9, TRC_IN / 8, tr_dispatch(a, 4 * TRC_GU + 2 * TRC_DN + it * 8 + wave, lane)); } }
    GSYNC();
    PH(2) finalize_rows<0>(a, 8, ctlf + CW_SS2);
    GSYNC();
    PH(3) { pg8::Order S{(const char*)XB, (const char*)(ws + WS_WIN), 0, 0, 33, 49, 0, 0, 33 * 49, 33 * 49, 1, G, c, TS2048, 32, 0, 1, 1, 32};
      EpiZ E{Z, (float*)(ws + WS_IF), ctlf + CW_SS2};
      pg8::gemm_phase<EpiZ, pg8::Order, true, true>(lds, pg8::Gemm{DM}, S, E);
      { const int tidt = pg8::opaque_tid(), lane = tidt & 63, wave = tidt >> 6;
        QLOOP(ctlu + CW_Q + 7, (2 * TRC_GU) / 8, tr_dispatch(a, 2 * TRC_GU + it * 8 + wave, lane)); } }
    GSYNC();
    PH(4) {
      if (c < 128) mlstm_prompt(a, lds, c);
      QLOOP0(ctlu + CW_Q + 1, 512, mlstm_sample(a, lds, it));
      QLOOP0(ctlu + CW_Q + 2, 512, xatt_sample(a, lds, it));
      QLOOP0(ctlu + CW_Q + 3, 256, xatt_prompt(a, lds, it));
      { const int tid4 = pg8::opaque_tid(), lane = tid4 & 63, wave = tid4 >> 6;
        QLOOP0(ctlu + CW_Q + 4, 512, s5_wave<0>(a, lds + wave * 13312, it * 8 + wave, lane));
        QLOOP(ctlu + CW_Q + 5, 1024, s5_wave<2>(a, lds + wave * 13312, it * 8 + wave, lane));
        QLOOP(ctlu + CW_Q + 8, (TRC_GL + 3 * TRC_BR + TRC_WO) / 8, { const int w_ = it * 8 + wave; const int base_ = 4 * TRC_GU + 2 * TRC_DN + TRC_IN;
            tr_dispatch(a, w_ < TRC_GL ? base_ + w_ : base_ + 2 * TRC_MK + w_, lane); }); } }
    GSYNC();
    PH(5) { const int tid5 = pg8::opaque_tid(), lane = tid5 & 63, wave = tid5 >> 6; for (int it = c; it < 512; it += G) s5_wave<1>(a, lds + wave * 13312, it * 8 + wave, lane);
            for (int tok = c * 8 + wave; tok < NPR; tok += G * 32) mlnorm_rows4(a, tok, G * 8, lane); }
    GSYNC();
    PH(6) { pg8::Order S{(const char*)(ws + WS_S5Y), (const char*)(ws + WS_WGLU), 0, 0, 33, 4, 0, 0, 132, 132, 1, G, c, TS1024, 16, 0, 1, 1, 32};
      EpiGLU E{(const bf16_t*)(ws + WS_S5Y), (bf16_t*)(ws + WS_S5O)};
      pg8::gemm_phase<EpiGLU, pg8::Order, true, true>(lds, pg8::Gemm{1024}, S, E); }
    GSYNC();
    PH(7) { pg8::Order S{(const char*)(ws + WS_S5O), (const char*)(ws + WS_WBR), (long)(17 * MiB), (long)DM * 1024 * 2, 32, 8, 0, 0, 256, 256, 3, G, c, TS1024, 16, 48, 2, 8, 32};
      EpiBR E{Z, (float*)(ws + WS_MERGED), (bf16_t*)(ws + WS_MB), (float*)(ws + WS_PART)};
      pg8::gemm_phase<EpiBR, pg8::Order, true, true>(lds, pg8::Gemm{1024}, S, E); }
    GSYNC();
    PH(7) finalize_rows<3>(a, 6, nullptr);
    GSYNC();
    PH(8) { pg8::Order S{(const char*)(ws + WS_MB), (const char*)(ws + WS_WOUT), 0, 0, 32, 8, 0, 0, 256, 256, 1, G, c, TS2048, 32, 64, 8, 16, 32};
      EpiRes<1> E{nullptr, nullptr, X, XB, ctlf + CW_SS3, (float*)(ws + WS_PART)};
      pg8::gemm_phase<EpiRes<1>, pg8::Order, true, true>(lds, pg8::Gemm{DM}, S, E); }
    GSYNC();
    PH(8) finalize_rows<1>(a, 8, ctlf + CW_SS3);
    GSYNC();
    PH(9) { pg8::Order S{(const char*)XB, (const char*)(ws + WS_W2GU), 0, 0, 33, 43, 0, 0, 33 * 43, 33 * 43, 1, G, c, TS2048, 32, 0, 1, 1, 32};
      EpiGU E{H, ctlf + CW_SS3, nullptr, nullptr, nullptr, nullptr, nullptr};
      pg8::gemm_phase<EpiGU, pg8::Order, true, true>(lds, pg8::Gemm{DM}, S, E);
      { const int tidt = pg8::opaque_tid(), lane = tidt & 63, wave = tidt >> 6;
        QLOOP(ctlu + CW_Q + 10, TRC_DN / 8, tr_dispatch(a, 4 * TRC_GU + TRC_DN + it * 8 + wave, lane)); } }
    GSYNC();
    PH(10) { pg8::Order S{(const char*)H, (const char*)(ws + WS_W2D), 0, 0, 32, 8, 0, 0, 256, 256, 1, G, c, TS5504, 86, 64, 8, 43, 32};
      EpiRes<2> E{nullptr, nullptr, X, nullptr, nullptr, (float*)(ws + WS_PART)};
      pg8::gemm_phase<EpiRes<2>, pg8::Order, true, true>(lds, pg8::Gemm{FF}, S, E); }
    GSYNC();
    PH(11) { const int tid11 = pg8::opaque_tid(), lane = tid11 & 63, wave = tid11 >> 6; const float* PART = (const float*)(ws + WS_PART);
      for (int row = c * 8 + wave; row < NT; row += G * 8) { f32x4 v[8]; float sq = 0.f;
#pragma unroll
        for (int q = 0; q < 8; ++q) { const int cc = 4 * (lane + 64 * q); v[q] = *(const f32x4*)(X + (size_t)row * DM + cc);
            if (row >= NPR) { f32x4 acc = (f32x4){0.f, 0.f, 0.f, 0.f};
#pragma unroll
                for (int sl = 0; sl < 8; ++sl) acc = acc + *(const f32x4*)(PART + ((size_t)sl * 128 + (row - NPR)) * DM + cc);
                v[q] = v[q] + acc * 0.5f; }
            sq += (v[q][0] * v[q][0] + v[q][1] * v[q][1]) + (v[q][2] * v[q][2] + v[q][3] * v[q][3]); }
        const float rstd = rsqrtf(wave_sum(sq) * (1.0f / DM) + EPS);
#pragma unroll
        for (int q = 0; q < 8; ++q) { const int cc = 4 * (lane + 64 * q); const f32x4 gf = *(const f32x4*)(a.in[I_GFIN] + cc); *(f32x4*)(a.out + O_Y + (size_t)row * DM + cc) = v[q] * rstd * gf; } } }
}

extern "C" void kernel_launch(void* const* d_in, const int* in_sizes, int n_in, void* d_out, int out_size, void* d_ws, size_t ws_size, hipStream_t stream) {
    static int grid = 0;
    if (grid == 0) {
        if (n_in != 40 || out_size != (int)O_END || ws_size < WS_END) { fprintf(stderr, "kernel_launch: unexpected problem (n_in %d, out %d, ws %zu)\n", n_in, out_size, ws_size); grid = -1; return; }
        int dev = 0, cus = 0, per_cu = 0;
        hipGetDevice(&dev); hipDeviceGetAttribute(&cus, hipDeviceAttributeMultiprocessorCount, dev);
        hipFuncSetAttribute((const void*)hybrid_fwd, hipFuncAttributeMaxDynamicSharedMemorySize, LDS_BYTES);
        hipOccupancyMaxActiveBlocksPerMultiprocessor(&per_cu, (const void*)hybrid_fwd, 512, LDS_BYTES);
        (void)hipGetLastError();
        if (per_cu < 1) per_cu = 1;
        grid = cus * per_cu;
        if (grid != 256) { fprintf(stderr, "kernel_launch: this build needs a 256-workgroup grid (got %d)\n", grid); grid = -1; return; }
        fprintf(stderr, "kernel_launch: %d CUs x %d = grid %d\n", cus, per_cu, grid);
    }
    if (grid < 0) return;
    if (hipMemsetAsync((char*)d_ws + WS_CTL + (size_t)CW_BAR * 4, 0, 3456 * 4, stream) != hipSuccess) { fprintf(stderr, "kernel_launch: memset of the barrier words failed\n"); return; }
    Args a{};
    for (int i = 0; i < 40; ++i) a.in[i] = (const float*)d_in[i];
    a.out = (float*)d_out; a.ws = (unsigned char*)d_ws;
    void* args[] = {&a};
    hipError_t e = hipLaunchCooperativeKernel((const void*)hybrid_fwd, dim3(grid), dim3(512), args, LDS_BYTES, stream);
    if (e != hipSuccess) fprintf(stderr, "cooperative launch failed: %s (grid %d)\n", hipGetErrorString(e), grid);
}
```
